# Optimizing an MI355X kernel written in HIP

```python
import jax, jax.numpy as jnp
from jax import lax
import numpy as np

D_MODEL = 1024
BATCH = 8
SEQ = 2048
DEPTH = 1

A_HEADS = 16
A_KV_HEADS = 2
A_HEAD_DIM = 64
A_GROUP = A_HEADS // A_KV_HEADS
A_WIDTH = A_HEADS * A_HEAD_DIM
A_KV_WIDTH = A_KV_HEADS * A_HEAD_DIM
WINDOW = 128
BLOCK = 128
ROPE_THETA = 10000.0

B_HEADS = 4
B_QK_WIDTH = D_MODEL // 2
B_V_WIDTH = D_MODEL
B_KEY_DIM = B_QK_WIDTH // B_HEADS
B_VAL_DIM = B_V_WIDTH // B_HEADS
GATE_RANK = 16
GATE_TAU = 16.0
CHUNK = 64

EPS = 1e-5
NEG_INF = -1e30

IN_SPLITS = (A_WIDTH, A_KV_WIDTH, A_KV_WIDTH, A_WIDTH,
             B_QK_WIDTH, B_QK_WIDTH, B_V_WIDTH, B_V_WIDTH,
             GATE_RANK,
             D_MODEL, D_MODEL)
IN_WIDTH = (2 * A_WIDTH + 2 * A_KV_WIDTH + 2 * B_QK_WIDTH + 2 * B_V_WIDTH
            + GATE_RANK + 2 * D_MODEL)

kernel_name = 'hybrid_swa_sink_gla_gated_block'


def rms_norm(x, w):
    xf = x.astype(jnp.float32)
    y = xf * lax.rsqrt(jnp.mean(xf * xf, axis=-1, keepdims=True) + EPS)
    return (y * w.astype(jnp.float32)).astype(x.dtype)


def rope(x, positions):
    half = A_HEAD_DIM // 2
    inv_freq = ROPE_THETA ** (-jnp.arange(half, dtype=jnp.float32) / half)
    ang = positions.astype(jnp.float32)[..., None] * inv_freq
    cos = jnp.cos(ang)[:, :, None, :]
    sin = jnp.sin(ang)[:, :, None, :]
    xf = x.astype(jnp.float32)
    x1, x2 = xf[..., :half], xf[..., half:]
    return jnp.concatenate([x1 * cos - x2 * sin, x2 * cos + x1 * sin], axis=-1).astype(x.dtype)


def sliding_window_attention(q, k, v, sinks):
    bsz, t = q.shape[0], q.shape[1]
    nb = t // BLOCK
    qb = q.reshape(bsz, nb, BLOCK, A_KV_HEADS, A_GROUP, A_HEAD_DIM)
    kb = k.reshape(bsz, nb, BLOCK, A_KV_HEADS, A_HEAD_DIM)
    vb = v.reshape(bsz, nb, BLOCK, A_KV_HEADS, A_HEAD_DIM)
    pad = ((0, 0), (1, 0), (0, 0), (0, 0), (0, 0))
    keys = jnp.concatenate([jnp.pad(kb, pad)[:, :-1], kb], axis=2)
    vals = jnp.concatenate([jnp.pad(vb, pad)[:, :-1], vb], axis=2)
    s = jnp.einsum('bnqhgd,bnkhd->bnhgqk', qb, keys).astype(jnp.float32) * (A_HEAD_DIM ** -0.5)
    qi = jnp.arange(BLOCK)[:, None]
    ki = jnp.arange(2 * BLOCK)[None, :]
    rel = qi + BLOCK - ki
    band = (rel >= 0) & (rel < WINDOW)
    blk = jnp.arange(nb)[:, None, None]
    valid = band[None] & ((blk > 0) | (ki >= BLOCK)[None])
    s = jnp.where(valid[None, :, None, None], s, NEG_INF)
    sink = jnp.broadcast_to(
        sinks.astype(jnp.float32).reshape(A_KV_HEADS, A_GROUP)[None, None, :, :, None, None],
        s.shape[:-1] + (1,))
    p = jax.nn.softmax(jnp.concatenate([s, sink], axis=-1), axis=-1)[..., :-1]
    o = jnp.einsum('bnhgqk,bnkhd->bnqhgd', p.astype(v.dtype), vals)
    return o.reshape(bsz, t, A_WIDTH)


def gated_linear_attention(q, k, v, log_a):
    bsz, t = q.shape[0], q.shape[1]
    n = t // CHUNK

    def chunks(a):
        return a.astype(jnp.float32).reshape(bsz, n, CHUNK, B_HEADS, -1).transpose(0, 1, 3, 2, 4)

    qc = chunks(q) * (B_KEY_DIM ** -0.5)
    kc, vc = chunks(k), chunks(v)
    b = jnp.cumsum(chunks(log_a), axis=3)
    b_last = b[:, :, :, -1:, :]
    q_e = qc * jnp.exp(b)
    k_e = kc * jnp.exp(-b)
    k_s = kc * jnp.exp(b_last - b)
    causal = jnp.tril(jnp.ones((CHUNK, CHUNK), dtype=bool))
    att = jnp.where(causal, jnp.einsum('bnhid,bnhjd->bnhij', q_e, k_e), 0.0)
    o_intra = jnp.einsum('bnhij,bnhjv->bnhiv', att, vc)
    inc = jnp.einsum('bnhjd,bnhjv->bnhdv', k_s, vc)
    decay = jnp.exp(b_last[:, :, :, 0, :])

    def step(state, inp):
        dec, dS = inp
        return dec[..., None] * state + dS, state

    s0 = jnp.zeros((bsz, B_HEADS, B_KEY_DIM, B_VAL_DIM), jnp.float32)
    _, states = lax.scan(step, s0, (decay.transpose(1, 0, 2, 3), inc.transpose(1, 0, 2, 3, 4)))
    states = states.transpose(1, 0, 2, 3, 4)
    o = o_intra + jnp.einsum('bnhid,bnhdv->bnhiv', q_e, states)
    return o.transpose(0, 1, 3, 2, 4).reshape(bsz, t, B_HEADS, B_VAL_DIM)


def setup_inputs(seed: int = 0) -> dict:
    key = jax.random.key(seed)
    ks = jax.random.split(key, 13)
    f32 = jnp.float32

    def lin(k, shape, fan_in):
        return jax.random.normal(k, shape, f32) * (fan_in ** -0.5)

    x = jax.random.normal(ks[0], (BATCH, SEQ, D_MODEL), f32)
    positions = jnp.broadcast_to(jnp.arange(SEQ, dtype=jnp.int32)[None, :], (BATCH, SEQ))
    norm_w = 1.0 + 0.02 * jax.random.normal(ks[1], (DEPTH, D_MODEL), f32)
    w_in = lin(ks[2], (DEPTH, D_MODEL, IN_WIDTH), D_MODEL)
    a_sinks = 0.5 * jax.random.normal(ks[3], (DEPTH, A_HEADS), f32)
    b_gate_up = lin(ks[4], (DEPTH, GATE_RANK, B_QK_WIDTH), GATE_RANK)
    b_gate_bias = 0.1 * jax.random.normal(ks[5], (DEPTH, B_QK_WIDTH), f32)
    b_out_norm_w = 1.0 + 0.02 * jax.random.normal(ks[6], (DEPTH, B_VAL_DIM), f32)
    w_a_proj = lin(ks[7], (DEPTH, A_WIDTH, D_MODEL), A_WIDTH)
    w_b_proj = lin(ks[8], (DEPTH, B_V_WIDTH, D_MODEL), B_V_WIDTH)
    w_out = lin(ks[9], (DEPTH, D_MODEL, D_MODEL), D_MODEL)
    final_norm_w = 1.0 + 0.02 * jax.random.normal(ks[10], (D_MODEL,), f32)
    return {'x': x, 'positions': positions, 'norm_w': norm_w, 'w_in': w_in,
            'a_sinks': a_sinks, 'b_gate_up': b_gate_up, 'b_gate_bias': b_gate_bias,
            'b_out_norm_w': b_out_norm_w, 'w_a_proj': w_a_proj, 'w_b_proj': w_b_proj,
            'w_out': w_out, 'final_norm_w': final_norm_w}


def reference(x, positions, norm_w, w_in, a_sinks, b_gate_up, b_gate_bias,
              b_out_norm_w, w_a_proj, w_b_proj, w_out, final_norm_w):
    bsz, t = x.shape[0], x.shape[1]
    offsets = [int(o) for o in np.cumsum(IN_SPLITS)[:-1]]
    for layer in range(DEPTH):
        h = rms_norm(x, norm_w[layer])
        proj = jnp.einsum('btd,de->bte', h, w_in[layer])
        (a_q, a_k, a_v, a_gate, b_q, b_k, b_v, b_gate, b_low,
         m_a, m_b) = jnp.split(proj, offsets, axis=-1)

        q = rope(a_q.reshape(bsz, t, A_HEADS, A_HEAD_DIM), positions)
        k = rope(a_k.reshape(bsz, t, A_KV_HEADS, A_HEAD_DIM), positions)
        v = a_v.reshape(bsz, t, A_KV_HEADS, A_HEAD_DIM)
        o_a = sliding_window_attention(q, k, v, a_sinks[layer]) * jax.nn.silu(a_gate)
        y_a = jnp.einsum('bte,ed->btd', o_a, w_a_proj[layer])

        gk = jnp.einsum('btr,re->bte', b_low, b_gate_up[layer]) + b_gate_bias[layer]
        log_a = jax.nn.log_sigmoid(gk.astype(jnp.float32)) / GATE_TAU
        o_b = gated_linear_attention(b_q.reshape(bsz, t, B_HEADS, B_KEY_DIM),
                                     b_k.reshape(bsz, t, B_HEADS, B_KEY_DIM),
                                     b_v.reshape(bsz, t, B_HEADS, B_VAL_DIM),
                                     log_a.reshape(bsz, t, B_HEADS, B_KEY_DIM))
        o_b = rms_norm(o_b.astype(x.dtype), b_out_norm_w[layer]).reshape(bsz, t, B_V_WIDTH)
        o_b = o_b * jax.nn.silu(b_gate)
        y_b = jnp.einsum('bte,ed->btd', o_b, w_b_proj[layer])

        merged = jax.nn.sigmoid(m_a) * y_a + jax.nn.sigmoid(m_b) * y_b
        x = x + jnp.einsum('btd,de->bte', merged, w_out[layer])
    return rms_norm(x, final_norm_w)
```

```cpp
#include <hip/hip_runtime.h>
#include <hip/hip_cooperative_groups.h>
#include <cstdio>
#include <cstdint>
#include <cmath>
namespace cg = cooperative_groups;
constexpr int NWAVES = 8;
constexpr int BATCH = 8, T = 2048, D = 1024, M = BATCH * T;
constexpr int N1 = 7936;
constexpr int INW = 7440;
constexpr float EPS = 1e-5f;
constexpr size_t MiB = 1u << 20;
constexpr size_t WS_CTL = 0, CTL_ZERO_BYTES = 128 * 1024;
constexpr size_t WS_SS2 = 256 * 1024;
constexpr size_t WS_W1 = 1 * MiB;
constexpr size_t WS_WA = WS_W1 + (size_t)N1 * 1024 * 2, WS_WB = WS_WA + 2 * MiB, WS_WO = WS_WB + 2 * MiB;
constexpr size_t WS_XN = 23 * MiB;
constexpr size_t WS_Q = 55 * MiB;
constexpr size_t WS_KV = 87 * MiB;
constexpr size_t WS_BQ = 95 * MiB, WS_BK = 111 * MiB;
constexpr size_t WS_BV = 127 * MiB;
constexpr size_t WS_AG = 159 * MiB;
constexpr size_t WS_BG = 191 * MiB;
constexpr size_t WS_LOGA = 223 * MiB;
constexpr size_t WS_END = 255 * MiB;
constexpr size_t WS_YA = WS_Q;
static_assert(WS_WO + 2 * MiB <= WS_XN && WS_YA + 64 * MiB <= WS_BV, "ws map");
constexpr int CW_BAR = 4096;
namespace pg8 {
#define PG8_LAS __attribute__((address_space(3)))
typedef unsigned short bf16_t;
typedef short bf16x8 __attribute__((ext_vector_type(8)));
typedef float f32x4 __attribute__((ext_vector_type(4)));
typedef unsigned u32x4 __attribute__((ext_vector_type(4)));
constexpr int BM = 256, BK = 64, HALF = 128, HTB = HALF * BK * 2  , STAGE_BYTES = 8 * HTB, NXCD = 8, WGM = 8;

__host__ __device__ __forceinline__ int lds_byte(int r, int c) { const int st = (r >> 4) * 2 + (c >> 5), rr = r & 15, cc = c & 31, ob = rr * 64 + cc * 2; return st * 1024 + (ob ^ (((ob >> 9) & 1) << 5)); }
__host__ __device__ __forceinline__ void stage_rc(int b, int& R, int& C) { const int st = b / 1024, sb = b % 1024, swz = sb ^ (((sb >> 9) & 1) << 5); R = (st >> 1) * 16 + swz / 64; C = (st & 1) * 32 + (swz % 64) / 2; }
__host__ __device__ __forceinline__ int perm32(int rho) { const int n = rho >> 4, i = rho & 15; return 8 * (i >> 2) + 4 * n + (i & 3); }

struct Unit { int pm, pn; };
struct Gemm { const bf16_t* A; const bf16_t* Bt; int M, N, K; };

struct StaticOrder {
    int nM, nN, nwg, G, c;
    __host__ __device__ void init(int M, int N, int G_, int c_) { nM = M / BM; nN = N / BM; nwg = nM * nN; G = G_; c = c_; }
    __host__ __device__ bool next(int i, Unit& u) const {
        const long L = (long)i * G + c; if (L >= nwg) return false;
        int wgid = (int)L; { const int q = nwg / NXCD, r = nwg % NXCD, xcd = wgid % NXCD, off = wgid / NXCD; wgid = (xcd < r ? xcd * (q + 1) : r * (q + 1) + (xcd - r) * q) + off; }
        const int nig = WGM * nN, gid = wgid / nig, fm = gid * WGM, gsz = (nM - fm) < WGM ? (nM - fm) : WGM;
        u.pm = fm + ((wgid % nig) % gsz); u.pn = (wgid % nig) / gsz; return true;
    }
    __device__ __forceinline__ void a_ready(const Unit&) const {}
    __device__ __forceinline__ void done(const Unit&) const {}
};


__device__ __forceinline__ unsigned cvt_pk_bf16(float lo, float hi) { unsigned r; asm volatile("v_cvt_pk_bf16_f32 %0, %1, %2" : "=v"(r) : "v"(lo), "v"(hi)); return r; }
__device__ __forceinline__ float bf_lo(unsigned w) { return __uint_as_float(w << 16); }
__device__ __forceinline__ float bf_hi(unsigned w) { return __uint_as_float(w & 0xffff0000u); }
__device__ __forceinline__ void store8bf(bf16_t* p, const f32x4& v0, const f32x4& v1) {
    u32x4 w; w.x = cvt_pk_bf16(v0[0], v0[1]); w.y = cvt_pk_bf16(v0[2], v0[3]); w.z = cvt_pk_bf16(v1[0], v1[1]); w.w = cvt_pk_bf16(v1[2], v1[3]); *(u32x4*)p = w;
}
__device__ __forceinline__ void load8bf(const bf16_t* p, f32x4& v0, f32x4& v1) {
    const u32x4 w = *(const u32x4*)p;
    v0 = (f32x4){bf_lo(w.x), bf_hi(w.x), bf_lo(w.y), bf_hi(w.y)}; v1 = (f32x4){bf_lo(w.z), bf_hi(w.z), bf_lo(w.w), bf_hi(w.w)};
}
__device__ __forceinline__ void sincos_cw(float a, float& s, float& c) {
    const float kf = rintf(a * 0.63661977236758134f);
    float r = fmaf(-kf, 1.5703125f, a); r = fmaf(-kf, 4.837512969970703125e-4f, r); r = fmaf(-kf, 7.54978995489188216e-8f, r);
    const float r2 = r * r;
    float sp = fmaf(r2, 2.7557319e-6f, -1.9841270e-4f); sp = fmaf(sp, r2, 8.3333333e-3f); sp = fmaf(sp, r2, -1.6666667e-1f); sp = fmaf(sp * r2, r, r);
    float cp = fmaf(r2, -2.7557319e-7f, 2.4801587e-5f); cp = fmaf(cp, r2, -1.3888889e-3f); cp = fmaf(cp, r2, 4.1666667e-2f); cp = fmaf(cp, r2, -0.5f); cp = fmaf(cp, r2, 1.0f);
    const int q = ((int)kf) & 3;
    const float s1 = (q & 1) ? cp : sp, c1 = (q & 1) ? sp : cp;
    s = (q & 2) ? -s1 : s1; c = ((q + 1) & 2) ? -c1 : c1;
}
constexpr float QSCALE = 0.125f * 1.4426950408889634f;
struct EpiP1 {
    static constexpr bool PERM = true, AFTER_DRAIN = false;
    unsigned char* ws; unsigned char* outb; const int* pos; const float* gbias;
    __device__ __forceinline__ void operator()(const f32x4 (&acc)[2][2][4][2], const Unit& u, int wr, int wc, int fr, int fq) const {
        const int pn = u.pn; const int row0 = u.pm * BM + wr * 64 + fr; const int cl = wc * 32 + 8 * fq;
        if (pn <= 4) {
            bf16_t* base = (bf16_t*)(ws + (pn < 4 ? WS_Q + (size_t)pn * 512 : WS_KV)); const int ld = pn < 4 ? 1024 : 256; const float sc = pn < 4 ? QSCALE : 1.0f;
            float invf[4];
#pragma unroll
            for (int i = 0; i < 4; ++i) invf[i] = exp2f(-(float)(16 * (wc & 1) + 4 * fq + i) * (13.287712379549449f / 32.0f));
#pragma unroll
            for (int ai = 0; ai < 2; ++ai)
#pragma unroll
                for (int m = 0; m < 4; ++m) {
                    const int row = row0 + ai * HALF + m * 16; const float pf = (float)pos[row];
                    f32x4 cs, sn;
#pragma unroll
                    for (int i = 0; i < 4; ++i) { float s_, c_; sincos_cw(pf * invf[i], s_, c_); cs[i] = c_ * sc; sn[i] = s_ * sc; }
#pragma unroll
                    for (int bj = 0; bj < 2; ++bj) {
                        const f32x4 x1 = acc[ai][bj][m][0], x2 = acc[ai][bj][m][1];
                        f32x4 o1, o2;
                        if (pn == 4 && bj == 1) { o1 = x1; o2 = x2; }
                        else { o1 = x1 * cs - x2 * sn; o2 = x2 * cs + x1 * sn; }
                        store8bf(base + (size_t)row * ld + bj * HALF + cl, o1, o2);
                    }
                }
        } else if (pn >= 29) {
            const int cgk = (pn - 29) * 256 + cl;
#pragma unroll
            for (int bj = 0; bj < 2; ++bj) {
                const f32x4 b0 = *(const f32x4*)(gbias + cgk + bj * HALF), b1 = *(const f32x4*)(gbias + cgk + bj * HALF + 4);
#pragma unroll
                for (int ai = 0; ai < 2; ++ai)
#pragma unroll
                    for (int m = 0; m < 4; ++m) {
                        const int row = row0 + ai * HALF + m * 16;
                        f32x4 g0 = acc[ai][bj][m][0] + b0, g1 = acc[ai][bj][m][1] + b1;
#pragma unroll
                        for (int i = 0; i < 4; ++i) {
                            g0[i] = (fminf(g0[i], 0.f) - log1pf(__expf(-fabsf(g0[i])))) * 0.0625f;
                            g1[i] = (fminf(g1[i], 0.f) - log1pf(__expf(-fabsf(g1[i])))) * 0.0625f;
                        }
                        float* p = (float*)(ws + WS_LOGA) + (size_t)row * 512 + cgk + bj * HALF;
                        *(f32x4*)p = g0; *(f32x4*)(p + 4) = g1;
                    }
            }
        } else {
            const size_t off = pn < 9 ? WS_AG + (size_t)(pn - 5) * 512 : pn < 11 ? WS_BQ + (size_t)(pn - 9) * 512 : pn < 13 ? WS_BK + (size_t)(pn - 11) * 512 : pn < 17 ? WS_BV + (size_t)(pn - 13) * 512
                             : pn < 21 ? WS_BG + (size_t)(pn - 17) * 512 : pn < 25 ? (size_t)(pn - 21) * 512 : (size_t)M * 2048 + (size_t)(pn - 25) * 512;
            const int ld = (pn >= 9 && pn < 13) ? 512 : 1024; const int act = pn < 9 ? 1 : pn < 17 ? 0 : pn < 21 ? 1 : 2;
            bf16_t* base = (bf16_t*)((pn < 21 ? ws : outb) + off) + cl;
#pragma unroll
            for (int ai = 0; ai < 2; ++ai)
#pragma unroll
                for (int m = 0; m < 4; ++m) {
                    const int row = row0 + ai * HALF + m * 16;
#pragma unroll
                    for (int bj = 0; bj < 2; ++bj) {
                        f32x4 v0 = acc[ai][bj][m][0], v1 = acc[ai][bj][m][1];
                        if (act) {
#pragma unroll
                            for (int i = 0; i < 4; ++i) {
                                const float s0 = __builtin_amdgcn_rcpf(1.0f + __expf(-v0[i])), s1 = __builtin_amdgcn_rcpf(1.0f + __expf(-v1[i]));
                                v0[i] = act == 1 ? v0[i] * s0 : s0; v1[i] = act == 1 ? v1[i] * s1 : s1;
                            }
                        }
                        store8bf(base + (size_t)row * ld + bj * HALF, v0, v1);
                    }
                }
        }
    }
};
struct EpiScaleF32 {
    static constexpr bool PERM = true, AFTER_DRAIN = false;
    const bf16_t* G; float* Y;
    __device__ __forceinline__ void operator()(const f32x4 (&acc)[2][2][4][2], const Unit& u, int wr, int wc, int fr, int fq) const {
        const int row0 = u.pm * BM + wr * 64 + fr; const int col0 = u.pn * BM + wc * 32 + 8 * fq;
#pragma unroll
        for (int ai = 0; ai < 2; ++ai)
#pragma unroll
            for (int m = 0; m < 4; ++m) {
                const size_t ro = (size_t)(row0 + ai * HALF + m * 16) * 1024 + col0;
#pragma unroll
                for (int bj = 0; bj < 2; ++bj) {
                    f32x4 g0, g1; load8bf(G + ro + bj * HALF, g0, g1);
                    *(f32x4*)(Y + ro + bj * HALF) = acc[ai][bj][m][0] * g0; *(f32x4*)(Y + ro + bj * HALF + 4) = acc[ai][bj][m][1] * g1;
                }
            }
    }
};
struct EpiMerge {
    static constexpr bool PERM = true, AFTER_DRAIN = false;
    const bf16_t* G; const float* Y; bf16_t* O;
    __device__ __forceinline__ void operator()(const f32x4 (&acc)[2][2][4][2], const Unit& u, int wr, int wc, int fr, int fq) const {
        const int row0 = u.pm * BM + wr * 64 + fr; const int col0 = u.pn * BM + wc * 32 + 8 * fq;
#pragma unroll
        for (int ai = 0; ai < 2; ++ai)
#pragma unroll
            for (int m = 0; m < 4; ++m) {
                const size_t ro = (size_t)(row0 + ai * HALF + m * 16) * 1024 + col0;
#pragma unroll
                for (int bj = 0; bj < 2; ++bj) {
                    f32x4 g0, g1; load8bf(G + ro + bj * HALF, g0, g1);
                    const f32x4 y0 = *(const f32x4*)(Y + ro + bj * HALF), y1 = *(const f32x4*)(Y + ro + bj * HALF + 4);
                    store8bf(O + ro + bj * HALF, y0 + acc[ai][bj][m][0] * g0, y1 + acc[ai][bj][m][1] * g1);
                }
            }
    }
};
struct EpiOut {
    static constexpr bool PERM = true, AFTER_DRAIN = false;
    const float* X; float* O; float* SS;
    __device__ __forceinline__ void operator()(const f32x4 (&acc)[2][2][4][2], const Unit& u, int wr, int wc, int fr, int fq) const {
        const int row0 = u.pm * BM + wr * 64 + fr; const int col0 = u.pn * BM + wc * 32 + 8 * fq;
#pragma unroll
        for (int ai = 0; ai < 2; ++ai)
#pragma unroll
            for (int m = 0; m < 4; ++m) {
                const int row = row0 + ai * HALF + m * 16; const size_t ro = (size_t)row * 1024 + col0; float ss = 0.f;
#pragma unroll
                for (int bj = 0; bj < 2; ++bj) {
                    const f32x4 x0 = *(const f32x4*)(X + ro + bj * HALF), x1 = *(const f32x4*)(X + ro + bj * HALF + 4);
                    const f32x4 o0 = x0 + acc[ai][bj][m][0], o1 = x1 + acc[ai][bj][m][1];
                    *(f32x4*)(O + ro + bj * HALF) = o0; *(f32x4*)(O + ro + bj * HALF + 4) = o1;
                    ss += (o0[0] * o0[0] + o0[1] * o0[1]) + (o0[2] * o0[2] + o0[3] * o0[3]) + (o1[0] * o1[0] + o1[1] * o1[1]) + (o1[2] * o1[2] + o1[3] * o1[3]);
                }
                ss += __shfl_xor(ss, 16); ss += __shfl_xor(ss, 32);
                if (fq == 0) atomicAdd(SS + row, ss);
            }
    }
};
template <class Epi, class Sched, bool ALIGN_EPI = false, bool SP2 = false>
__device__ __forceinline__ void gemm_phase(PG8_LAS unsigned char* lds, const Gemm g, const Sched& S, const Epi& E) {
    const int tid = threadIdx.x, wid = __builtin_amdgcn_readfirstlane(tid >> 6), lane = tid & 63, wr = wid >> 2, wc = wid & 3, fr = lane & 15, fq = lane >> 4;
    const int K = g.K, nt = K / BK;
    unsigned voffA[2], voffB[2];
#pragma unroll
    for (int i = 0; i < 2; ++i) { int R, C; stage_rc(tid * 16 + i * 8192, R, C); const int Rb = Epi::PERM ? ((R & ~31) + perm32(R & 31)) : R;
        voffA[i] = (unsigned)(R * K + C) * 2u; voffB[i] = (unsigned)(Rb * K + C) * 2u; }
    const size_t kstep = (size_t)(BK * 2);
    const size_t hstep = (size_t)HALF * K * 2;
    const size_t tstep = 2 * hstep;
    const unsigned ldsw = (unsigned)wid * 1024u;
    const int aoff = lds_byte(wr * 64 + fr, fq * 8), boff = lds_byte(wc * 32 + fr, fq * 8);
#define PG8_SA(b, h) (((b) * 2 + (h)) * HTB)
#define PG8_SB(b, h) ((4 + (b) * 2 + (h)) * HTB)
#define PG8_STAGE(bufoff, gbase, voff) do { _Pragma("unroll") for (int _i = 0; _i < 2; ++_i) \
        __builtin_amdgcn_global_load_lds((const unsigned*)((const char*)(gbase) + (voff)[_i]), (PG8_LAS unsigned*)(lds + (bufoff) + ldsw + _i * 8192), 16, 0, 0); } while (0)
#define PG8_LDA(dst, b, h) do { _Pragma("unroll") for (int m = 0; m < 4; ++m) _Pragma("unroll") for (int k = 0; k < 2; ++k) dst[m][k] = *(const PG8_LAS bf16x8*)(lds + PG8_SA(b, h) + aoff + m * 2048 + k * 1024); } while (0)
#define PG8_LDB(dst, b, h) do { _Pragma("unroll") for (int n = 0; n < 2; ++n) _Pragma("unroll") for (int k = 0; k < 2; ++k) dst[n][k] = *(const PG8_LAS bf16x8*)(lds + PG8_SB(b, h) + boff + n * 2048 + k * 1024); } while (0)
#define PG8_MMA(ai, bj, At, Bt) do { __builtin_amdgcn_s_setprio(1); _Pragma("unroll") for (int m = 0; m < 4; ++m) _Pragma("unroll") for (int n = 0; n < 2; ++n) _Pragma("unroll") for (int k = 0; k < 2; ++k) \
        acc[ai][bj][m][n] = __builtin_amdgcn_mfma_f32_16x16x32_bf16(Bt[n][k], At[m][k], acc[ai][bj][m][n], 0, 0, 0); __builtin_amdgcn_s_setprio(0); } while (0)
#define PG8_WAIT_V(n) asm volatile("s_waitcnt vmcnt(" #n ")" ::: "memory")
#define PG8_WAIT_L(n) asm volatile("s_waitcnt lgkmcnt(" #n ")" ::: "memory")
#define PG8_BAR __builtin_amdgcn_s_barrier()
#define PG8_SCHED __builtin_amdgcn_sched_barrier(0)
    Unit cur, nxt; int ui = 0;
    if (!S.next(0, cur)) return;
    f32x4 acc[2][2][4][2];
#pragma unroll
    for (int a = 0; a < 2; ++a)
#pragma unroll
        for (int b = 0; b < 2; ++b)
#pragma unroll
            for (int m = 0; m < 4; ++m)
#pragma unroll
                for (int n = 0; n < 2; ++n) acc[a][b][m][n] = (f32x4){0.f, 0.f, 0.f, 0.f};
    bf16x8 At[4][2], B0[2][2], B1[2][2];
    const char* cA = (const char*)g.A + (size_t)cur.pm * tstep; const char* cB = (const char*)g.Bt + (size_t)cur.pn * tstep;
    S.a_ready(cur);
    if constexpr (SP2) {
        PG8_STAGE(PG8_SB(0, 0), cB, voffB); PG8_STAGE(PG8_SB(0, 1), cB + hstep, voffB); PG8_STAGE(PG8_SA(0, 0), cA, voffA); PG8_STAGE(PG8_SA(0, 1), cA + hstep, voffA);
        if (wr == 1) PG8_BAR;
        PG8_WAIT_V(2); PG8_BAR;
        PG8_STAGE(PG8_SB(1, 0), cB + kstep, voffB); PG8_STAGE(PG8_SA(1, 0), cA + kstep, voffA); PG8_STAGE(PG8_SB(1, 1), cB + hstep + kstep, voffB);
        PG8_WAIT_V(6); PG8_BAR;
    } else {
        PG8_STAGE(PG8_SB(0, 0), cB, voffB); PG8_STAGE(PG8_SA(0, 0), cA, voffA); PG8_STAGE(PG8_SB(0, 1), cB + hstep, voffB); PG8_STAGE(PG8_SA(0, 1), cA + hstep, voffA);
        if (wr == 1) PG8_BAR;
        PG8_WAIT_V(4); PG8_BAR;
        PG8_STAGE(PG8_SB(1, 0), cB + kstep, voffB); PG8_STAGE(PG8_SA(1, 0), cA + kstep, voffA); PG8_STAGE(PG8_SB(1, 1), cB + hstep + kstep, voffB);
        PG8_WAIT_V(6); PG8_BAR;
    }
    for (;;) {
        const bool has_next = S.next(ui + 1, nxt);
        const char* nA = has_next ? (const char*)g.A + (size_t)nxt.pm * tstep : cA; const char* nB = has_next ? (const char*)g.Bt + (size_t)nxt.pn * tstep : cB;
        for (int t = 0; t < nt; t += 2) {
            const bool last = (t == nt - 2);
            const char* a1 = cA + (size_t)(t + 1) * kstep;
            const char* a2 = last ? nA : cA + (size_t)(t + 2) * kstep; const char* b2 = last ? nB : cB + (size_t)(t + 2) * kstep;
            const char* a3 = a2 + kstep; const char* b3 = b2 + kstep;
            if (last && has_next) S.a_ready(nxt);
            if constexpr (SP2) {
            PG8_LDB(B0, 0, 0); PG8_LDB(B1, 0, 1); PG8_SCHED; PG8_LDA(At, 0, 0); PG8_STAGE(PG8_SA(1, 1), a1 + hstep, voffA);
            PG8_WAIT_V(8); PG8_WAIT_L(0); PG8_BAR; PG8_MMA(0, 0, At, B0); PG8_MMA(0, 1, At, B1); PG8_BAR; PG8_SCHED;
            PG8_LDA(At, 0, 1); PG8_STAGE(PG8_SB(0, 0), b2, voffB); PG8_STAGE(PG8_SB(0, 1), b2 + hstep, voffB); PG8_STAGE(PG8_SA(0, 0), a2, voffA);
            PG8_WAIT_V(8); PG8_WAIT_L(0); PG8_BAR; PG8_MMA(1, 0, At, B0); PG8_MMA(1, 1, At, B1); PG8_BAR; PG8_SCHED;
            PG8_LDB(B0, 1, 0); PG8_LDB(B1, 1, 1); PG8_SCHED; PG8_LDA(At, 1, 0); PG8_STAGE(PG8_SA(0, 1), a2 + hstep, voffA);
            PG8_WAIT_V(8); PG8_WAIT_L(0); PG8_BAR; PG8_MMA(0, 0, At, B0); PG8_MMA(0, 1, At, B1); PG8_BAR; PG8_SCHED;
            PG8_LDA(At, 1, 1); PG8_STAGE(PG8_SB(1, 0), b3, voffB); PG8_STAGE(PG8_SB(1, 1), b3 + hstep, voffB); PG8_STAGE(PG8_SA(1, 0), a3, voffA);
            PG8_WAIT_V(8); PG8_WAIT_L(0); PG8_BAR; PG8_MMA(1, 0, At, B0); PG8_MMA(1, 1, At, B1); PG8_BAR; PG8_SCHED;
            } else {
            PG8_LDB(B0, 0, 0); PG8_SCHED; PG8_LDA(At, 0, 0); PG8_STAGE(PG8_SA(1, 1), a1 + hstep, voffA);
            PG8_WAIT_L(8); PG8_BAR; PG8_WAIT_L(0); PG8_MMA(0, 0, At, B0); PG8_BAR; PG8_SCHED;
            PG8_LDB(B1, 0, 1); PG8_STAGE(PG8_SB(0, 0), b2, voffB);
            PG8_BAR; PG8_WAIT_L(0); PG8_MMA(0, 1, At, B1); PG8_BAR;
            PG8_LDA(At, 0, 1); PG8_STAGE(PG8_SA(0, 0), a2, voffA);
            PG8_BAR; PG8_WAIT_L(0); PG8_MMA(1, 0, At, B0); PG8_BAR; PG8_SCHED;
            PG8_STAGE(PG8_SB(0, 1), b2 + hstep, voffB);
            PG8_WAIT_V(6); PG8_BAR; PG8_MMA(1, 1, At, B1); PG8_BAR;
            PG8_LDB(B0, 1, 0); PG8_SCHED; PG8_LDA(At, 1, 0); PG8_STAGE(PG8_SA(0, 1), a2 + hstep, voffA);
            PG8_WAIT_L(8); PG8_BAR; PG8_WAIT_L(0); PG8_MMA(0, 0, At, B0); PG8_BAR; PG8_SCHED;
            PG8_LDB(B1, 1, 1); PG8_STAGE(PG8_SB(1, 0), b3, voffB);
            PG8_BAR; PG8_WAIT_L(0); PG8_MMA(0, 1, At, B1); PG8_BAR;
            PG8_LDA(At, 1, 1); PG8_STAGE(PG8_SA(1, 0), a3, voffA);
            PG8_BAR; PG8_WAIT_L(0); PG8_MMA(1, 0, At, B0); PG8_BAR; PG8_SCHED;
            PG8_STAGE(PG8_SB(1, 1), b3 + hstep, voffB);
            PG8_WAIT_V(6); PG8_BAR; PG8_MMA(1, 1, At, B1); PG8_BAR;
            }
        }
        if constexpr (ALIGN_EPI) { if (wr == 0) PG8_BAR; }
        if constexpr (!Epi::AFTER_DRAIN) { E(acc, cur, wr, wc, fr, fq); S.done(cur); }
        if (!has_next) break;
#pragma unroll
        for (int a = 0; a < 2; ++a)
#pragma unroll
            for (int b = 0; b < 2; ++b)
#pragma unroll
                for (int m = 0; m < 4; ++m)
#pragma unroll
                    for (int n = 0; n < 2; ++n) acc[a][b][m][n] = (f32x4){0.f, 0.f, 0.f, 0.f};
        cur = nxt; cA = nA; cB = nB; ++ui;
        if constexpr (ALIGN_EPI) { if (wr == 1) PG8_BAR; }
    }
    PG8_WAIT_V(0);
    if constexpr (!ALIGN_EPI) { if (wr == 0) PG8_BAR; }
    PG8_BAR;
    if constexpr (Epi::AFTER_DRAIN) { E.fused(acc, cur, wr, wc, fr, fq, lds, wid, lane); S.done(cur); }
#undef PG8_SA
#undef PG8_SB
#undef PG8_STAGE
#undef PG8_LDA
#undef PG8_LDB
#undef PG8_MMA
#undef PG8_WAIT_V
#undef PG8_WAIT_L
#undef PG8_BAR
#undef PG8_SCHED
}
}
#define GAS __attribute__((address_space(1)))
#define LAS __attribute__((address_space(3)))
typedef unsigned short bf16;
typedef unsigned v4u __attribute__((ext_vector_type(4)));
typedef float f32x4 __attribute__((ext_vector_type(4)));
typedef short bf16x8 __attribute__((ext_vector_type(8)));
typedef GAS unsigned gu32;
typedef GAS unsigned long long gu64;
#define RLX_AGENT __ATOMIC_RELAXED, __HIP_MEMORY_SCOPE_AGENT
#define LDS_WAIT() asm volatile("s_waitcnt lgkmcnt(0)" ::: "memory")
#define VM_WAIT() asm volatile("s_waitcnt vmcnt(0)" ::: "memory")
__device__ __forceinline__ unsigned long long rt() { return __builtin_amdgcn_s_memrealtime(); }
__device__ __forceinline__ unsigned f2bf(float f) { unsigned u = __builtin_bit_cast(unsigned, f); return (u + 0x7fffu + ((u >> 16) & 1u)) >> 16; }
__device__ __forceinline__ unsigned pk2(float lo, float hi) { return f2bf(lo) | (f2bf(hi) << 16); }

#define XB_TMO      128
#define XB_XCNT(j)  (256  + 64 * (j))
#define XB_XSUB(j)  (1280 + 64 * (j))
#define XB_XGEN(j)  (2304 + 64 * (j))
#define XB_TOP      3328
#define XB_TOPGEN   3392
#define XCD_BAR_WORDS 3456
#define XB_SPIN_CAP (1u << 18)

__device__ __forceinline__ unsigned xb_ld(unsigned* p)              { return __hip_atomic_load(p, __ATOMIC_RELAXED, __HIP_MEMORY_SCOPE_AGENT); }
__device__ __forceinline__ unsigned xb_add(unsigned* p, unsigned v) { return __hip_atomic_fetch_add(p, v, __ATOMIC_RELAXED, __HIP_MEMORY_SCOPE_AGENT); }
__device__ __forceinline__ unsigned xb_xcc_id() { return (unsigned)__builtin_amdgcn_s_getreg((3 << 11) | 20) & 0xFu; }
#define XB_SPIN(cond, bar) do { unsigned _sp = 0; while (cond) { __builtin_amdgcn_s_sleep(1); \
    if ((++_sp & 255u) == 0u) { if (xb_ld(&(bar)[XB_TMO])) break; if (_sp > XB_SPIN_CAP) { atomicAdd(&(bar)[XB_TMO], 1u); break; } } } } while (0)

struct XcdBarrier {
    unsigned* bar; unsigned x;
    volatile LAS unsigned* st;
};

__device__ __forceinline__ XcdBarrier xcd_barrier_post(unsigned* bar, volatile LAS unsigned* st) {
    XcdBarrier b; b.bar = bar; b.x = xb_xcc_id(); b.st = st;
    if (threadIdx.x == 0) (void)xb_add(&bar[XB_XCNT(b.x)], 1u);
    return b;
}
__device__ __forceinline__ void xcd_barrier_complete(unsigned* bar, unsigned x, unsigned& nloc, unsigned& nx) {
    const unsigned G = gridDim.x * gridDim.y * gridDim.z;
    unsigned sum, cnt, mine, sp = 0u;
    for (;;) {
        sum = 0u; cnt = 0u; mine = 0u;
#pragma unroll
        for (unsigned j = 0; j < 16; ++j) { const unsigned c = xb_ld(&bar[XB_XCNT(j)]); sum += c; cnt += (c > 0u) ? 1u : 0u; mine = (j == x) ? c : mine; }
        if (sum == G) break;
        __builtin_amdgcn_s_sleep(1);
        if ((++sp & 255u) == 0u) { if (xb_ld(&bar[XB_TMO])) break; if (sp > XB_SPIN_CAP) { atomicAdd(&bar[XB_TMO], 1u); break; } }
    }
    nloc = mine > 0u ? mine : 1u; nx = cnt > 0u ? cnt : 1u;
}

__device__ __forceinline__ void xcd_barrier(const XcdBarrier& b) {
    asm volatile("s_waitcnt vmcnt(0)" ::: "memory");
    __syncthreads();
    if (threadIdx.x == 0) {
        unsigned* bar = b.bar;
        __builtin_amdgcn_s_waitcnt(0);
        unsigned nloc = b.st[0], nx = b.st[1];
        if (nloc == 0u) { xcd_barrier_complete(bar, b.x, nloc, nx); b.st[0] = nloc; b.st[1] = nx; }
        const unsigned old = xb_add(&bar[XB_XSUB(b.x)], 1u);
        const unsigned gen = old / nloc;
        if (old + 1u == (gen + 1u) * nloc) {
            __builtin_amdgcn_fence(__ATOMIC_RELEASE, "agent");
            asm volatile("s_waitcnt vmcnt(0)" ::: "memory");
            const unsigned og = xb_add(&bar[XB_TOP], 1u);
            const unsigned tg = og / nx;
            if (og + 1u == (tg + 1u) * nx) xb_add(&bar[XB_TOPGEN], 1u);
            else XB_SPIN(xb_ld(&bar[XB_TOPGEN]) == tg, bar);
            __builtin_amdgcn_fence(__ATOMIC_ACQUIRE, "agent");
            xb_add(&bar[XB_XGEN(b.x)], 1u);
            asm volatile("s_waitcnt vmcnt(0)" ::: "memory");
        } else {
            XB_SPIN(xb_ld(&bar[XB_XGEN(b.x)]) == gen, bar);
            __builtin_amdgcn_fence(__ATOMIC_ACQUIRE, "agent");
            asm volatile("s_waitcnt vmcnt(0)" ::: "memory");
        }
    }
    __syncthreads();
}
typedef unsigned u32x4 __attribute__((ext_vector_type(4)));

constexpr int RING_OFF = 0, RING_BYTES = 131072;
constexpr int LDSCTL_OFF = RING_BYTES, MISC_OFF = LDSCTL_OFF + 320;
constexpr int LDS_BYTES = 147456;

struct Frame {
    LAS unsigned char* lds;
    volatile LAS unsigned* MISC;
    int tid, lane, wave, vcu, G;
};

__device__ __forceinline__ float wave_sum(float v) {
#pragma unroll
    for (int o = 1; o < 64; o <<= 1) v += __shfl_xor(v, o);
    return v;
}
__device__ __forceinline__ int src_col_w1(int n) {
    if (n < 1152) { const int hh = n >> 6, p = n & 63; return hh * 64 + 4 * (p >> 3) + (p & 3) + 32 * ((p >> 2) & 1); }
    if (n < 5376) return n;
    return n + 16;
}
__device__ __forceinline__ void p0_transpose_item(const float* W, int ldw, int K, bf16* WT, int n0, int k0, int srccol, LAS float* scr, int lane) {
#pragma unroll 8
    for (int i = 0; i < 32; ++i) { const int kk = 2 * i + (lane >> 5); scr[kk * 33 + (lane & 31)] = W[(size_t)(k0 + kk) * ldw + srccol]; }
    LDS_WAIT(); asm volatile("" ::: "memory");
    const int c = lane & 7;
#pragma unroll
    for (int j = 0; j < 4; ++j) { const int n = (lane >> 3) + 8 * j; const LAS float* s = scr + (8 * c) * 33 + n;
        v4u o; o.x = pk2(s[0 * 33], s[1 * 33]); o.y = pk2(s[2 * 33], s[3 * 33]); o.z = pk2(s[4 * 33], s[5 * 33]); o.w = pk2(s[6 * 33], s[7 * 33]);
        *(GAS v4u*)(WT + (size_t)(n0 + n) * K + k0 + 8 * c) = o; }
    LDS_WAIT(); asm volatile("" ::: "memory");
}
__device__ __forceinline__ void p0_fold_item(const float* W, const float* up, bf16* WT, int e0, int k0, LAS float* scr, int lane) {
    float u[16];
#pragma unroll
    for (int r = 0; r < 16; ++r) u[r] = up[r * 512 + e0 + (lane & 31)];
#pragma unroll 4
    for (int i = 0; i < 32; ++i) { const int kk = 2 * i + (lane >> 5); const float* wr = W + (size_t)(k0 + kk) * INW + 5376; float a = 0.f;
#pragma unroll
        for (int r = 0; r < 16; ++r) a = fmaf(wr[r], u[r], a);
        scr[kk * 33 + (lane & 31)] = a; }
    LDS_WAIT(); asm volatile("" ::: "memory");
    const int c = lane & 7;
#pragma unroll
    for (int j = 0; j < 4; ++j) { const int n = (lane >> 3) + 8 * j; const LAS float* s = scr + (8 * c) * 33 + n;
        v4u o; o.x = pk2(s[0 * 33], s[1 * 33]); o.y = pk2(s[2 * 33], s[3 * 33]); o.z = pk2(s[4 * 33], s[5 * 33]); o.w = pk2(s[6 * 33], s[7 * 33]);
        *(GAS v4u*)(WT + (size_t)(7424 + e0 + n) * 1024 + k0 + 8 * c) = o; }
    LDS_WAIT(); asm volatile("" ::: "memory");
}
__device__ __forceinline__ void rms_row_to_bf16(int lane, const float* xrow, const float* w, bf16* orow) {
    const GAS f32x4* xr = (const GAS f32x4*)xrow + lane; const GAS f32x4* wr = (const GAS f32x4*)w + lane;
    f32x4 v[4]; float s = 0.f;
#pragma unroll
    for (int j = 0; j < 4; ++j) { v[j] = xr[64 * j]; s += (v[j].x * v[j].x + v[j].y * v[j].y) + (v[j].z * v[j].z + v[j].w * v[j].w); }
    const float rstd = 1.f / sqrtf(wave_sum(s) * (1.f / D) + EPS);
    GAS unsigned long long* o8 = (GAS unsigned long long*)orow + lane;
#pragma unroll
    for (int j = 0; j < 4; ++j) { const f32x4 ww = wr[64 * j];
        o8[64 * j] = (unsigned long long)pk2(v[j].x * rstd * ww.x, v[j].y * rstd * ww.y) | ((unsigned long long)pk2(v[j].z * rstd * ww.z, v[j].w * rstd * ww.w) << 32); }
}

typedef float f32x16 __attribute__((ext_vector_type(16)));
typedef short s16x4 __attribute__((ext_vector_type(4)));
typedef unsigned u32x2 __attribute__((ext_vector_type(2)));
__device__ __forceinline__ int crow(int r, int hi) { return (r & 3) + 8 * (r >> 2) + 4 * hi; }
constexpr int AT_KSTR = 144, AT_VSTR = 520, AT_K = 0, AT_V = 256 * AT_KSTR;
static_assert(AT_V + 64 * AT_VSTR <= RING_BYTES, "attention LDS");
__device__ __forceinline__ void attn_unit(LAS unsigned char* lds, int b, int nb, int g, const bf16* Q, const bf16* KV, bf16* AGO, const float* sinks) {
    const int tid = threadIdx.x, lane = tid & 63, r32 = lane & 31, hi = lane >> 5; const int wid = __builtin_amdgcn_readfirstlane(tid >> 6);
    const long tok0 = (long)b * T + nb * 128, key0 = tok0 - 128;
    const int jlo = nb > 0 ? 0 : 128;
#pragma unroll
    for (int i = 0; i < 4; ++i) { const int p = tid + 512 * i, key = p >> 3, ch = p & 7;
        if (key >= jlo) { const v4u v = *(const GAS v4u*)(KV + (key0 + key) * 256 + g * 64 + ch * 8); *(LAS v4u*)(lds + AT_K + key * AT_KSTR + ch * 16) = v; } }
#pragma unroll
    for (int i = 0; i < 4; ++i) { const int p = tid + 512 * i, key = p & 255, ch = p >> 8;
        if (key >= jlo) { const v4u v = *(const GAS v4u*)(KV + (key0 + key) * 256 + 128 + g * 64 + ch * 8);
            LAS unsigned short* vt = (LAS unsigned short*)(lds + AT_V + (ch * 8) * AT_VSTR + key * 2);
            vt[0 * (AT_VSTR / 2)] = (unsigned short)(v.x & 0xffff); vt[1 * (AT_VSTR / 2)] = (unsigned short)(v.x >> 16);
            vt[2 * (AT_VSTR / 2)] = (unsigned short)(v.y & 0xffff); vt[3 * (AT_VSTR / 2)] = (unsigned short)(v.y >> 16);
            vt[4 * (AT_VSTR / 2)] = (unsigned short)(v.z & 0xffff); vt[5 * (AT_VSTR / 2)] = (unsigned short)(v.z >> 16);
            vt[6 * (AT_VSTR / 2)] = (unsigned short)(v.w & 0xffff); vt[7 * (AT_VSTR / 2)] = (unsigned short)(v.w >> 16); } }
    __syncthreads();
    const int hq = g * 8 + wid; const float sink2 = sinks[hq] * 1.4426950408889634f;
    const float NEG = -INFINITY;
    for (int R = 0; R < 4; ++R) {
        const long qtok = tok0 + 32 * R + r32;
        bf16x8 qf[4];
#pragma unroll
        for (int s = 0; s < 4; ++s) qf[s] = *(const GAS bf16x8*)(Q + qtok * 1024 + hq * 64 + 16 * s + 8 * hi);
        f32x16 st[5];
#pragma unroll
        for (int tt = 0; tt < 5; ++tt) {
            const int Tt = R + tt; const bool active = (nb > 0) || (Tt >= 4);
#pragma unroll
            for (int r = 0; r < 16; ++r) st[tt][r] = 0.f;
            if (active) {
#pragma unroll
                for (int s = 0; s < 4; ++s) { const bf16x8 kf = *(const LAS bf16x8*)(lds + AT_K + (32 * Tt + r32) * AT_KSTR + (16 * s + 8 * hi) * 2);
                    st[tt] = __builtin_amdgcn_mfma_f32_32x32x16_bf16(kf, qf[s], st[tt], 0, 0, 0); }
            } else {
#pragma unroll
                for (int r = 0; r < 16; ++r) st[tt][r] = NEG;
            }
        }
#pragma unroll
        for (int r = 0; r < 16; ++r) { const int cr = crow(r, hi); if (!(cr > r32)) st[0][r] = NEG; if (!(cr <= r32)) st[4][r] = NEG; }
        float mx = sink2;
#pragma unroll
        for (int tt = 0; tt < 5; ++tt)
#pragma unroll
            for (int r = 0; r < 16; ++r) mx = fmaxf(mx, st[tt][r]);
        mx = fmaxf(mx, __shfl_xor(mx, 32));
        float l = 0.f;
#pragma unroll
        for (int tt = 0; tt < 5; ++tt)
#pragma unroll
            for (int r = 0; r < 16; ++r) { const float p = __builtin_amdgcn_exp2f(st[tt][r] - mx); st[tt][r] = p; l += p; }
        l += __shfl_xor(l, 32); l += __builtin_amdgcn_exp2f(sink2 - mx);
        const float inv_l = 1.0f / l;
        f32x16 o[2];
#pragma unroll
        for (int r = 0; r < 16; ++r) { o[0][r] = 0.f; o[1][r] = 0.f; }
#pragma unroll
        for (int tt = 0; tt < 5; ++tt) {
            const int Tt = R + tt; const bool active = (nb > 0) || (Tt >= 4);
            if (active) {
#pragma unroll
                for (int s = 0; s < 2; ++s) {
                    u32x4 pw; pw.x = pg8::cvt_pk_bf16(st[tt][8 * s + 0], st[tt][8 * s + 1]); pw.y = pg8::cvt_pk_bf16(st[tt][8 * s + 2], st[tt][8 * s + 3]);
                    pw.z = pg8::cvt_pk_bf16(st[tt][8 * s + 4], st[tt][8 * s + 5]); pw.w = pg8::cvt_pk_bf16(st[tt][8 * s + 6], st[tt][8 * s + 7]);
                    const bf16x8 pf = __builtin_bit_cast(bf16x8, pw);
#pragma unroll
                    for (int db = 0; db < 2; ++db) {
                        const LAS unsigned char* vp = lds + AT_V + (32 * db + r32) * AT_VSTR + (32 * Tt + 16 * s + 4 * hi) * 2;
                        const u32x2 a0 = *(const LAS u32x2*)vp, a1 = *(const LAS u32x2*)(vp + 16);
                        const u32x4 aw = (u32x4){a0.x, a0.y, a1.x, a1.y};
                        o[db] = __builtin_amdgcn_mfma_f32_32x32x16_bf16(__builtin_bit_cast(bf16x8, aw), pf, o[db], 0, 0, 0);
                    }
                }
            }
        }
#pragma unroll
        for (int db = 0; db < 2; ++db)
#pragma unroll
            for (int g4 = 0; g4 < 4; ++g4) {
                bf16* p = AGO + qtok * 1024 + hq * 64 + 32 * db + 8 * g4 + 4 * hi;
                const u32x2 gw = *(const GAS u32x2*)p;
                u32x2 ow; ow.x = pg8::cvt_pk_bf16(o[db][4 * g4 + 0] * inv_l * pg8::bf_lo(gw.x), o[db][4 * g4 + 1] * inv_l * pg8::bf_hi(gw.x));
                ow.y = pg8::cvt_pk_bf16(o[db][4 * g4 + 2] * inv_l * pg8::bf_lo(gw.y), o[db][4 * g4 + 3] * inv_l * pg8::bf_hi(gw.y));
                *(GAS u32x2*)p = ow;
            }
    }
    __syncthreads();
}

constexpr int GL_QSTR = 272, GL_TSTR = 144;
constexpr int GL_QE = 0, GL_KE = GL_QE + 64 * GL_QSTR, GL_KST = GL_KE + 64 * GL_QSTR, GL_VT = GL_KST + 128 * GL_TSTR, GL_ATT = GL_VT + 256 * GL_TSTR,
              GL_SEG = GL_ATT + 64 * GL_TSTR, GL_DEC = GL_SEG + 2048, GL_SS = GL_DEC + 512, GL_END = GL_SS + 2048;
static_assert(GL_END <= RING_BYTES, "GLA LDS");
__device__ __forceinline__ void gla_item(LAS unsigned char* lds, int b, int h, const bf16* BQ, const bf16* BK, const bf16* BV, const float* LOGA, bf16* BGO, const float* nw) {
    const int tid = threadIdx.x, lane = tid & 63, r32 = lane & 31, hi = lane >> 5; const int w = __builtin_amdgcn_readfirstlane(tid >> 6);
    f32x16 S[4];
#pragma unroll
    for (int kb = 0; kb < 4; ++kb)
#pragma unroll
        for (int r = 0; r < 16; ++r) S[kb][r] = 0.f;
    float nwr[16];
#pragma unroll
    for (int r = 0; r < 16; ++r) nwr[r] = nw[32 * w + crow(r, hi)];
    const int c = tid & 127, sg = tid >> 7, i0 = 16 * sg;
    const int dvi = tid & 255, th = tid >> 8;
    LAS float* SEG = (LAS float*)(lds + GL_SEG); LAS float* DEC = (LAS float*)(lds + GL_DEC); LAS float* SS = (LAS float*)(lds + GL_SS);
    for (int n = 0; n < 32; ++n) {
        const long tokc = (long)b * T + n * 64;
        float la[16];
#pragma unroll
        for (int i = 0; i < 16; ++i) la[i] = LOGA[(tokc + i0 + i) * 512 + h * 128 + c];
        unsigned short qraw[16], kraw[16];
#pragma unroll
        for (int i = 0; i < 16; ++i) { qraw[i] = BQ[(tokc + i0 + i) * 512 + h * 128 + c]; kraw[i] = BK[(tokc + i0 + i) * 512 + h * 128 + c]; }
        unsigned short vraw[32];
#pragma unroll
        for (int i = 0; i < 32; ++i) vraw[i] = BV[(tokc + 32 * th + i) * 1024 + h * 256 + dvi];
#pragma unroll
        for (int i = 1; i < 16; ++i) la[i] += la[i - 1];
        SEG[sg * 128 + c] = la[15];
        __syncthreads();
        float off = 0.f, blast = 0.f;
#pragma unroll
        for (int s = 0; s < 4; ++s) { const float v = SEG[s * 128 + c]; blast += v; if (s < sg) off += v; }
        if (sg == 0) DEC[c] = __expf(blast);
        {
            unsigned ksp[8];
#pragma unroll
            for (int i = 0; i < 16; i += 2) {
                const float b0 = off + la[i], b1 = off + la[i + 1];
                const float q0 = __uint_as_float((unsigned)qraw[i] << 16) * 0.08838834764831845f * __expf(b0), q1 = __uint_as_float((unsigned)qraw[i + 1] << 16) * 0.08838834764831845f * __expf(b1);
                const float k0 = __uint_as_float((unsigned)kraw[i] << 16), k1 = __uint_as_float((unsigned)kraw[i + 1] << 16);
                *(LAS unsigned short*)(lds + GL_QE + (i0 + i) * GL_QSTR + c * 2) = (unsigned short)f2bf(q0);
                *(LAS unsigned short*)(lds + GL_QE + (i0 + i + 1) * GL_QSTR + c * 2) = (unsigned short)f2bf(q1);
                *(LAS unsigned short*)(lds + GL_KE + (i0 + i) * GL_QSTR + c * 2) = (unsigned short)f2bf(k0 * __expf(-b0));
                *(LAS unsigned short*)(lds + GL_KE + (i0 + i + 1) * GL_QSTR + c * 2) = (unsigned short)f2bf(k1 * __expf(-b1));
                ksp[i >> 1] = pk2(k0 * __expf(blast - b0), k1 * __expf(blast - b1));
            }
            *(LAS v4u*)(lds + GL_KST + c * GL_TSTR + i0 * 2) = (v4u){ksp[0], ksp[1], ksp[2], ksp[3]};
            *(LAS v4u*)(lds + GL_KST + c * GL_TSTR + i0 * 2 + 16) = (v4u){ksp[4], ksp[5], ksp[6], ksp[7]};
        }
#pragma unroll
        for (int j = 0; j < 4; ++j) {
            v4u o; o.x = (unsigned)vraw[8 * j + 0] | ((unsigned)vraw[8 * j + 1] << 16); o.y = (unsigned)vraw[8 * j + 2] | ((unsigned)vraw[8 * j + 3] << 16);
            o.z = (unsigned)vraw[8 * j + 4] | ((unsigned)vraw[8 * j + 5] << 16); o.w = (unsigned)vraw[8 * j + 6] | ((unsigned)vraw[8 * j + 7] << 16);
            *(LAS v4u*)(lds + GL_VT + dvi * GL_TSTR + (32 * th + 8 * j) * 2) = o;
        }
        __syncthreads();
        if (w < 3) {
            const int I = (w + 1) >> 1, J = w >> 1;
            f32x16 a;
#pragma unroll
            for (int r = 0; r < 16; ++r) a[r] = 0.f;
#pragma unroll
            for (int s = 0; s < 8; ++s) {
                const bf16x8 kf = *(const LAS bf16x8*)(lds + GL_KE + (32 * J + r32) * GL_QSTR + (16 * s + 8 * hi) * 2);
                const bf16x8 qf = *(const LAS bf16x8*)(lds + GL_QE + (32 * I + r32) * GL_QSTR + (16 * s + 8 * hi) * 2);
                a = __builtin_amdgcn_mfma_f32_32x32x16_bf16(kf, qf, a, 0, 0, 0);
            }
#pragma unroll
            for (int g4 = 0; g4 < 4; ++g4) {
                float v[4];
#pragma unroll
                for (int e = 0; e < 4; ++e) { const int jj = 32 * J + 8 * g4 + 4 * hi + e, ii = 32 * I + r32; v[e] = (jj <= ii) ? a[4 * g4 + e] : 0.f; }
                u32x2 ow; ow.x = pk2(v[0], v[1]); ow.y = pk2(v[2], v[3]);
                *(LAS u32x2*)(lds + GL_ATT + (32 * I + r32) * GL_TSTR + (32 * J + 8 * g4 + 4 * hi) * 2) = ow;
            }
        }
        __syncthreads();
        bf16x8 vf[4];
#pragma unroll
        for (int s = 0; s < 4; ++s) vf[s] = *(const LAS bf16x8*)(lds + GL_VT + (32 * w + r32) * GL_TSTR + (16 * s + 8 * hi) * 2);
        f32x16 oT[2];
#pragma unroll
        for (int r = 0; r < 16; ++r) { oT[0][r] = 0.f; oT[1][r] = 0.f; }
#pragma unroll
        for (int I = 0; I < 2; ++I) {
#pragma unroll
            for (int s = 0; s < 4; ++s) {
                if (I == 0 && s >= 2) continue;
                const bf16x8 af = *(const LAS bf16x8*)(lds + GL_ATT + (32 * I + r32) * GL_TSTR + (16 * s + 8 * hi) * 2);
                oT[I] = __builtin_amdgcn_mfma_f32_32x32x16_bf16(vf[s], af, oT[I], 0, 0, 0);
            }
        }
#pragma unroll
        for (int kb = 0; kb < 4; ++kb)
#pragma unroll
            for (int s2 = 0; s2 < 2; ++s2) {
                u32x4 sw; sw.x = pk2(S[kb][8 * s2 + 0], S[kb][8 * s2 + 1]); sw.y = pk2(S[kb][8 * s2 + 2], S[kb][8 * s2 + 3]);
                sw.z = pk2(S[kb][8 * s2 + 4], S[kb][8 * s2 + 5]); sw.w = pk2(S[kb][8 * s2 + 6], S[kb][8 * s2 + 7]);
                const bf16x8 sf = __builtin_bit_cast(bf16x8, sw);
#pragma unroll
                for (int I = 0; I < 2; ++I) {
                    const LAS unsigned char* qp = lds + GL_QE + (32 * I + r32) * GL_QSTR + (32 * kb + 16 * s2 + 4 * hi) * 2;
                    const u32x2 a0 = *(const LAS u32x2*)qp, a1 = *(const LAS u32x2*)(qp + 16);
                    const u32x4 qw = (u32x4){a0.x, a0.y, a1.x, a1.y};
                    oT[I] = __builtin_amdgcn_mfma_f32_32x32x16_bf16(sf, __builtin_bit_cast(bf16x8, qw), oT[I], 0, 0, 0);
                }
            }
#pragma unroll
        for (int kb = 0; kb < 4; ++kb) {
#pragma unroll
            for (int r = 0; r < 16; ++r) S[kb][r] *= DEC[32 * kb + crow(r, hi)];
#pragma unroll
            for (int s = 0; s < 4; ++s) {
                const bf16x8 kf = *(const LAS bf16x8*)(lds + GL_KST + (32 * kb + r32) * GL_TSTR + (16 * s + 8 * hi) * 2);
                S[kb] = __builtin_amdgcn_mfma_f32_32x32x16_bf16(kf, vf[s], S[kb], 0, 0, 0);
            }
        }
#pragma unroll
        for (int I = 0; I < 2; ++I) { float ss = 0.f;
#pragma unroll
            for (int r = 0; r < 16; ++r) ss += oT[I][r] * oT[I][r];
            ss += __shfl_xor(ss, 32);
            if (hi == 0) SS[w * 64 + 32 * I + r32] = ss; }
        __syncthreads();
#pragma unroll
        for (int I = 0; I < 2; ++I) {
            float tot = 0.f;
#pragma unroll
            for (int ww = 0; ww < 8; ++ww) tot += SS[ww * 64 + 32 * I + r32];
            const float rstd = 1.0f / sqrtf(tot * (1.0f / 256.0f) + EPS);
            const long tok = tokc + 32 * I + r32;
#pragma unroll
            for (int g4 = 0; g4 < 4; ++g4) {
                bf16* p = BGO + tok * 1024 + h * 256 + 32 * w + 8 * g4 + 4 * hi;
                const u32x2 gw = *(const GAS u32x2*)p;
                u32x2 ow; ow.x = pk2(oT[I][4 * g4 + 0] * rstd * nwr[4 * g4 + 0] * pg8::bf_lo(gw.x), oT[I][4 * g4 + 1] * rstd * nwr[4 * g4 + 1] * pg8::bf_hi(gw.x));
                ow.y = pk2(oT[I][4 * g4 + 2] * rstd * nwr[4 * g4 + 2] * pg8::bf_lo(gw.y), oT[I][4 * g4 + 3] * rstd * nwr[4 * g4 + 3] * pg8::bf_hi(gw.y));
                *(GAS u32x2*)p = ow;
            }
        }
    }
    __syncthreads();
}

struct Args { const float* in[12]; float* out; unsigned char* ws; int ph_lo, ph_hi, use_cg, pad; };
constexpr int N_PHASES = 6;
__global__ void __launch_bounds__(NWAVES * 64, 2) hybrid_fwd(Args args) {
    extern __shared__ __attribute__((aligned(16))) unsigned char lds[];
    Frame F;
    F.lds = (LAS unsigned char*)lds;
    F.MISC = (volatile LAS unsigned*)(F.lds + MISC_OFF);
    F.tid = threadIdx.x; F.lane = F.tid & 63; F.wave = __builtin_amdgcn_readfirstlane(F.tid >> 6);
    F.G = gridDim.x; { const int bx = blockIdx.x; F.vcu = (F.G % 8 == 0) ? (bx % 8) * (F.G / 8) + bx / 8 : bx; }
    unsigned char* ws = args.ws;
    gu32* ctl = (gu32*)(ws + WS_CTL);
    const float* x = args.in[0]; const int* positions = (const int*)args.in[1]; const float* norm_w = args.in[2]; const float* w_in = args.in[3];
    const float* a_sinks = args.in[4]; const float* b_gate_up = args.in[5]; const float* b_gate_bias = args.in[6]; const float* b_out_norm_w = args.in[7];
    const float* w_a_proj = args.in[8]; const float* w_b_proj = args.in[9]; const float* w_out = args.in[10]; const float* final_norm_w = args.in[11];
    bf16* W1t = (bf16*)(ws + WS_W1); bf16* Wat = (bf16*)(ws + WS_WA); bf16* Wbt = (bf16*)(ws + WS_WB); bf16* Wot = (bf16*)(ws + WS_WO);
    bf16* XN = (bf16*)(ws + WS_XN); bf16* Qb = (bf16*)(ws + WS_Q); bf16* KVb = (bf16*)(ws + WS_KV); bf16* BQb = (bf16*)(ws + WS_BQ); bf16* BKb = (bf16*)(ws + WS_BK);
    bf16* BVb = (bf16*)(ws + WS_BV); bf16* AGb = (bf16*)(ws + WS_AG); bf16* BGb = (bf16*)(ws + WS_BG); float* LOGA = (float*)(ws + WS_LOGA);
    float* YA = (float*)(ws + WS_YA); bf16* MERGED = XN; float* SS2 = (float*)(ws + WS_SS2);
    bf16* MAb = (bf16*)args.out; bf16* MBb = MAb + (size_t)M * 1024;
    for (int u = F.tid; u < (LDS_BYTES - LDSCTL_OFF) / 4; u += NWAVES * 64) ((LAS unsigned*)(F.lds + LDSCTL_OFF))[u] = 0u;
    __syncthreads();
    XcdBarrier bar = xcd_barrier_post((unsigned*)(ctl + CW_BAR), F.MISC + 8);
    const int lo = args.ph_lo, hi = args.ph_hi;
#define IN(k) (lo <= (k) && (k) < hi)
#define BOTH(k) (IN(k) && IN((k) + 1))
#define GRID_BAR() do { if (args.use_cg) cg::this_grid().sync(); else xcd_barrier(bar); } while (0)

    if (IN(0)) {
        LAS float* scr = (LAS float*)(F.lds + RING_OFF + F.wave * 16384);
        const int gw = F.vcu * NWAVES + F.wave, NGW = F.G * NWAVES;
        constexpr int I_1 = 16 * (7424 / 32), I_F = 16 * (512 / 32), I_S = 16 * 32;
        constexpr int NITEMS = I_1 + I_F + 3 * I_S;
        for (int it = gw; it < NITEMS; it += NGW) {
            int r = it;
            if (r < I_1) { const int kb = r / 232, nb = r % 232; p0_transpose_item(w_in, INW, 1024, W1t, 32 * nb, 64 * kb, src_col_w1(32 * nb + (F.lane & 31)), scr, F.lane); continue; } r -= I_1;
            if (r < I_F) { const int kb = r / 16, eb = r % 16; p0_fold_item(w_in, b_gate_up, W1t, 32 * eb, 64 * kb, scr, F.lane); continue; } r -= I_F;
            const int mat = r / I_S; r -= mat * I_S; const int kb = r / 32, nb = r % 32;
            const float* Wsrc = mat == 0 ? w_a_proj : (mat == 1 ? w_b_proj : w_out); bf16* Wdst = mat == 0 ? Wat : (mat == 1 ? Wbt : Wot);
            p0_transpose_item(Wsrc, 1024, 1024, Wdst, 32 * nb, 64 * kb, 32 * nb + (F.lane & 31), scr, F.lane);
        }
        for (int m = gw; m < M; m += NGW) rms_row_to_bf16(F.lane, x + (size_t)m * D, norm_w, XN + (size_t)m * D);
        for (int i = blockIdx.x * 512 + F.tid; i < M; i += F.G * 512) SS2[i] = 0.f;
        if (BOTH(0)) GRID_BAR();
    }
    if (IN(1)) {
        pg8::Gemm g{XN, W1t, M, N1, D}; pg8::StaticOrder S; S.init(M, N1, F.G, (int)blockIdx.x);
        pg8::EpiP1 E{ws, (unsigned char*)args.out, positions, b_gate_bias};
        pg8::gemm_phase<pg8::EpiP1, pg8::StaticOrder, true, true>(F.lds + RING_OFF, g, S, E);
        if (BOTH(1)) GRID_BAR();
    }
    if (IN(2)) {
        const int bx = blockIdx.x;
        if (F.G >= 64) {
            if (bx < 32) gla_item(F.lds + RING_OFF, bx >> 2, bx & 3, BQb, BKb, BVb, LOGA, BGb, b_out_norm_w);
            else for (int u = bx - 32; u < 256; u += F.G - 32) attn_unit(F.lds + RING_OFF, u >> 5, (u >> 1) & 15, u & 1, Qb, KVb, AGb, a_sinks);
        } else {
            for (int u = bx; u < 32; u += F.G) gla_item(F.lds + RING_OFF, u >> 2, u & 3, BQb, BKb, BVb, LOGA, BGb, b_out_norm_w);
            for (int u = bx; u < 256; u += F.G) attn_unit(F.lds + RING_OFF, u >> 5, (u >> 1) & 15, u & 1, Qb, KVb, AGb, a_sinks);
        }
        if (BOTH(2)) GRID_BAR();
    }
    if (IN(3)) {
        { pg8::Gemm g{AGb, Wat, M, D, D}; pg8::StaticOrder S; S.init(M, D, F.G, (int)blockIdx.x);
          pg8::EpiScaleF32 E{MAb, YA};
          pg8::gemm_phase<pg8::EpiScaleF32, pg8::StaticOrder, true, true>(F.lds + RING_OFF, g, S, E); }
        { pg8::Gemm g{BGb, Wbt, M, D, D}; pg8::StaticOrder S; S.init(M, D, F.G, (int)blockIdx.x);
          pg8::EpiMerge E{MBb, YA, MERGED};
          pg8::gemm_phase<pg8::EpiMerge, pg8::StaticOrder, true, true>(F.lds + RING_OFF, g, S, E); }
        if (BOTH(3)) GRID_BAR();
    }
    if (IN(4)) {
        pg8::Gemm g{MERGED, Wot, M, D, D}; pg8::StaticOrder S; S.init(M, D, F.G, (int)blockIdx.x);
        pg8::EpiOut E{x, args.out, SS2};
        pg8::gemm_phase<pg8::EpiOut, pg8::StaticOrder, true, true>(F.lds + RING_OFF, g, S, E);
        if (BOTH(4)) GRID_BAR();
    }
    if (IN(5)) {
        const int gw = blockIdx.x * NWAVES + F.wave, NGW = F.G * NWAVES;
        for (int m = gw; m < M; m += NGW) {
            const float rstd = 1.0f / sqrtf(SS2[m] * (1.0f / D) + EPS);
            GAS f32x4* o = (GAS f32x4*)(args.out + (size_t)m * D) + F.lane; const GAS f32x4* fw = (const GAS f32x4*)final_norm_w + F.lane;
#pragma unroll
            for (int j = 0; j < 4; ++j) o[64 * j] = o[64 * j] * rstd * fw[64 * j];
        }
    }
#undef IN
#undef BOTH
}

#ifndef MK_N_LAUNCHES
#define MK_N_LAUNCHES 6
#endif
#ifndef MK_USE_CG
#define MK_USE_CG 1
#endif
extern "C" void kernel_launch(void* const* d_in, const int* in_sizes, int n_in, void* d_out, int out_size, void* d_ws, size_t ws_size, hipStream_t stream) {
    static int grid = 0;
    if (grid == 0) {
        if (n_in != 12 || in_sizes[0] != M * D || out_size != M * D || ws_size < WS_END) { fprintf(stderr, "kernel_launch: unexpected shapes (n_in %d, in0 %d, out %d, ws %zu)\n", n_in, n_in > 0 ? in_sizes[0] : -1, out_size, ws_size); grid = -1; return; }
        int dev = 0, cus = 0, per_cu = 0;
        if (hipGetDevice(&dev) != hipSuccess || hipDeviceGetAttribute(&cus, hipDeviceAttributeMultiprocessorCount, dev) != hipSuccess) { grid = -1; return; }
        if (hipFuncSetAttribute((const void*)hybrid_fwd, hipFuncAttributeMaxDynamicSharedMemorySize, LDS_BYTES) != hipSuccess) { fprintf(stderr, "kernel_launch: hipFuncSetAttribute failed\n"); grid = -1; return; }
        if (hipOccupancyMaxActiveBlocksPerMultiprocessor(&per_cu, (const void*)hybrid_fwd, NWAVES * 64, LDS_BYTES) != hipSuccess || per_cu < 1) { fprintf(stderr, "kernel_launch: occupancy query says %d\n", per_cu); per_cu = 1; }
        (void)hipGetLastError();
        grid = cus;
    }
    if (grid < 0) return;
    if (hipMemsetAsync((char*)d_ws + WS_CTL, 0, CTL_ZERO_BYTES, stream) != hipSuccess) { fprintf(stderr, "kernel_launch: memset failed\n"); return; }
    Args a{};
    for (int i = 0; i < 12; ++i) a.in[i] = (const float*)d_in[i];
    a.out = (float*)d_out; a.ws = (unsigned char*)d_ws; a.use_cg = MK_USE_CG; a.pad = 0;
    if (MK_N_LAUNCHES == 1) {
        a.ph_lo = 0; a.ph_hi = N_PHASES;
        void* kargs[] = {&a};
        hipError_t e = hipLaunchCooperativeKernel((const void*)hybrid_fwd, dim3(grid), dim3(NWAVES * 64), kargs, LDS_BYTES, stream);
        if (e != hipSuccess) fprintf(stderr, "kernel_launch: cooperative launch failed: %s (grid %d)\n", hipGetErrorString(e), grid);
    } else {
        for (int li = 0; li < N_PHASES; ++li) {
            a.ph_lo = li; a.ph_hi = li + 1;
            hipLaunchKernelGGL(hybrid_fwd, dim3(grid), dim3(NWAVES * 64), LDS_BYTES, stream, a);
        }
    }
}
```

```cpp
#include <hip/hip_runtime.h>
#include <hip/hip_cooperative_groups.h>
#include <cstdio>
#include <cstdint>
#include <cmath>
namespace cg = cooperative_groups;
constexpr int NWAVES = 8;
constexpr int BATCH = 8, T = 2048, D = 1024, M = BATCH * T;
constexpr int N1 = 7936;
constexpr int INW = 7440;
constexpr float EPS = 1e-5f;
constexpr size_t MiB = 1u << 20;
constexpr size_t WS_CTL = 0, CTL_ZERO_BYTES = 128 * 1024;
constexpr size_t WS_SS2 = 256 * 1024;
constexpr size_t WS_SSB = 512 * 1024;
constexpr size_t WS_W1 = 1 * MiB;
constexpr size_t WS_WA = WS_W1 + (size_t)N1 * 1024 * 2, WS_WB = WS_WA + 2 * MiB, WS_WO = WS_WB + 2 * MiB;
constexpr size_t WS_XN = 23 * MiB;
constexpr size_t WS_Q = 55 * MiB;
constexpr size_t WS_KV = 87 * MiB;
constexpr size_t WS_BQ = 95 * MiB, WS_BK = 111 * MiB;
constexpr size_t WS_BV = 127 * MiB;
constexpr size_t WS_AG = 159 * MiB;
constexpr size_t WS_BG = 191 * MiB;
constexpr size_t WS_LOGA = 223 * MiB;
constexpr size_t WS_END = 255 * MiB;
constexpr size_t WS_YA = WS_Q;
static_assert(WS_WO + 2 * MiB <= WS_XN && WS_YA + 64 * MiB <= WS_BV, "ws map");
constexpr int CW_BAR = 4096, CW_PANEL = 8192, CW_GLA = 12288;
namespace pg8 {
#define PG8_LAS __attribute__((address_space(3)))
typedef unsigned short bf16_t;
typedef short bf16x8 __attribute__((ext_vector_type(8)));
typedef float f32x4 __attribute__((ext_vector_type(4)));
typedef unsigned u32x4 __attribute__((ext_vector_type(4)));
constexpr int BM = 256, BK = 64, HALF = 128, HTB = HALF * BK * 2  , STAGE_BYTES = 8 * HTB, NXCD = 8, WGM = 8;

__host__ __device__ __forceinline__ int lds_byte(int r, int c) { const int st = (r >> 4) * 2 + (c >> 5), rr = r & 15, cc = c & 31, ob = rr * 64 + cc * 2; return st * 1024 + (ob ^ (((ob >> 9) & 1) << 5)); }
__host__ __device__ __forceinline__ void stage_rc(int b, int& R, int& C) { const int st = b / 1024, sb = b % 1024, swz = sb ^ (((sb >> 9) & 1) << 5); R = (st >> 1) * 16 + swz / 64; C = (st & 1) * 32 + (swz % 64) / 2; }
__host__ __device__ __forceinline__ int perm32(int rho) { const int n = rho >> 4, i = rho & 15; return 8 * (i >> 2) + 4 * n + (i & 3); }

struct Unit { int pm, pn, seg; };
struct Gemm { const bf16_t* A; const bf16_t* Bt; int M, N, K, ld; };

struct StaticOrder {
    int nM, nN, nwg, G, c;
    __host__ __device__ void init(int M, int N, int G_, int c_) { nM = M / BM; nN = N / BM; nwg = nM * nN; G = G_; c = c_; }
    __host__ __device__ bool next(int i, Unit& u) const {
        const long L = (long)i * G + c; if (L >= nwg) return false;
        int wgid = (int)L; { const int q = nwg / NXCD, r = nwg % NXCD, xcd = wgid % NXCD, off = wgid / NXCD; wgid = (xcd < r ? xcd * (q + 1) : r * (q + 1) + (xcd - r) * q) + off; }
        const int nig = WGM * nN, gid = wgid / nig, fm = gid * WGM, gsz = (nM - fm) < WGM ? (nM - fm) : WGM;
        u.pm = fm + ((wgid % nig) % gsz); u.pn = (wgid % nig) / gsz; u.seg = 0; return true;
    }
    __device__ __forceinline__ void a_ready(const Unit&) const {}
    __device__ __forceinline__ void done(const Unit&) const {}
};


struct StaticOrder2 {
    StaticOrder in;
    __host__ __device__ void init(int M, int N, int G_, int c_) { in.init(M, N, G_, c_); }
    __host__ __device__ bool next(int i, Unit& u) const { if (!in.next(i >> 1, u)) return false; u.seg = i & 1; return true; }
    __device__ __forceinline__ void a_ready(const Unit&) const {}
    __device__ __forceinline__ void done(const Unit&) const {}
};

__device__ __forceinline__ unsigned cvt_pk_bf16(float lo, float hi) { unsigned r; asm volatile("v_cvt_pk_bf16_f32 %0, %1, %2" : "=v"(r) : "v"(lo), "v"(hi)); return r; }
__device__ __forceinline__ float bf_lo(unsigned w) { return __uint_as_float(w << 16); }
__device__ __forceinline__ float bf_hi(unsigned w) { return __uint_as_float(w & 0xffff0000u); }
__device__ __forceinline__ void store8bf(bf16_t* p, const f32x4& v0, const f32x4& v1) {
    u32x4 w; w.x = cvt_pk_bf16(v0[0], v0[1]); w.y = cvt_pk_bf16(v0[2], v0[3]); w.z = cvt_pk_bf16(v1[0], v1[1]); w.w = cvt_pk_bf16(v1[2], v1[3]); *(u32x4*)p = w;
}
__device__ __forceinline__ void load8bf(const bf16_t* p, f32x4& v0, f32x4& v1) {
    const u32x4 w = *(const u32x4*)p;
    v0 = (f32x4){bf_lo(w.x), bf_hi(w.x), bf_lo(w.y), bf_hi(w.y)}; v1 = (f32x4){bf_lo(w.z), bf_hi(w.z), bf_lo(w.w), bf_hi(w.w)};
}
__device__ __forceinline__ void sincos_cw(float a, float& s, float& c) {
    const float kf = rintf(a * 0.63661977236758134f);
    float r = fmaf(-kf, 1.5703125f, a); r = fmaf(-kf, 4.837512969970703125e-4f, r); r = fmaf(-kf, 7.54978995489188216e-8f, r);
    const float r2 = r * r;
    float sp = fmaf(r2, 2.7557319e-6f, -1.9841270e-4f); sp = fmaf(sp, r2, 8.3333333e-3f); sp = fmaf(sp, r2, -1.6666667e-1f); sp = fmaf(sp * r2, r, r);
    float cp = fmaf(r2, -2.7557319e-7f, 2.4801587e-5f); cp = fmaf(cp, r2, -1.3888889e-3f); cp = fmaf(cp, r2, 4.1666667e-2f); cp = fmaf(cp, r2, -0.5f); cp = fmaf(cp, r2, 1.0f);
    const int q = ((int)kf) & 3;
    const float s1 = (q & 1) ? cp : sp, c1 = (q & 1) ? sp : cp;
    s = (q & 2) ? -s1 : s1; c = ((q + 1) & 2) ? -c1 : c1;
}
constexpr float QSCALE = 0.125f * 1.4426950408889634f;
struct EpiP1 {
    static constexpr bool PERM = true, AFTER_DRAIN = false;
    unsigned char* ws; unsigned char* outb; const int* pos; const float* gbias;
    __device__ __forceinline__ void operator()(const f32x4 (&acc)[2][2][4][2], const Unit& u, int wr, int wc, int fr, int fq) const {
        const int pn = u.pn; const int row0 = u.pm * BM + wr * 64 + fr; const int cl = wc * 32 + 8 * fq;
        if (pn <= 4) {
            bf16_t* base = (bf16_t*)(ws + (pn < 4 ? WS_Q + (size_t)pn * 512 : WS_KV)); const int ld = pn < 4 ? 1024 : 256; const float sc = pn < 4 ? QSCALE : 1.0f;
            float invf[4];
#pragma unroll
            for (int i = 0; i < 4; ++i) invf[i] = exp2f(-(float)(16 * (wc & 1) + 4 * fq + i) * (13.287712379549449f / 32.0f));
#pragma unroll
            for (int ai = 0; ai < 2; ++ai)
#pragma unroll
                for (int m = 0; m < 4; ++m) {
                    const int row = row0 + ai * HALF + m * 16; const float pf = (float)pos[row];
                    f32x4 cs, sn;
#pragma unroll
                    for (int i = 0; i < 4; ++i) { float s_, c_; sincos_cw(pf * invf[i], s_, c_); cs[i] = c_ * sc; sn[i] = s_ * sc; }
#pragma unroll
                    for (int bj = 0; bj < 2; ++bj) {
                        const f32x4 x1 = acc[ai][bj][m][0], x2 = acc[ai][bj][m][1];
                        f32x4 o1, o2;
                        if (pn == 4 && bj == 1) { o1 = x1; o2 = x2; }
                        else { o1 = x1 * cs - x2 * sn; o2 = x2 * cs + x1 * sn; }
                        store8bf(base + (size_t)row * ld + bj * HALF + cl, o1, o2);
                    }
                }
        } else if (pn >= 29) {
            const int cgk = (pn - 29) * 256 + cl;
#pragma unroll
            for (int bj = 0; bj < 2; ++bj) {
                const f32x4 b0 = *(const f32x4*)(gbias + cgk + bj * HALF), b1 = *(const f32x4*)(gbias + cgk + bj * HALF + 4);
#pragma unroll
                for (int ai = 0; ai < 2; ++ai)
#pragma unroll
                    for (int m = 0; m < 4; ++m) {
                        const int row = row0 + ai * HALF + m * 16;
                        f32x4 g0 = acc[ai][bj][m][0] + b0, g1 = acc[ai][bj][m][1] + b1;
#pragma unroll
                        for (int i = 0; i < 4; ++i) {
                            g0[i] = (fminf(g0[i], 0.f) - __logf(1.0f + __expf(-fabsf(g0[i])))) * 0.0625f;
                            g1[i] = (fminf(g1[i], 0.f) - __logf(1.0f + __expf(-fabsf(g1[i])))) * 0.0625f;
                        }
                        float* p = (float*)(ws + WS_LOGA) + (size_t)row * 512 + cgk + bj * HALF;
                        *(f32x4*)p = g0; *(f32x4*)(p + 4) = g1;
                    }
            }
        } else {
            const size_t off = pn < 9 ? WS_AG + (size_t)(pn - 5) * 512 : pn < 11 ? WS_BQ + (size_t)(pn - 9) * 512 : pn < 13 ? WS_BK + (size_t)(pn - 11) * 512 : pn < 17 ? WS_BV + (size_t)(pn - 13) * 512
                             : pn < 21 ? WS_AG + 2048 + (size_t)(pn - 17) * 512 : pn < 25 ? (size_t)(pn - 21) * 512 : (size_t)M * 2048 + (size_t)(pn - 25) * 512;
            const int ld = (pn >= 9 && pn < 13) ? 512 : (pn < 9 || (pn >= 17 && pn < 21)) ? 2048 : 1024; const int act = pn < 9 ? 1 : pn < 17 ? 0 : pn < 21 ? 1 : 2;
            bf16_t* base = (bf16_t*)((pn < 21 ? ws : outb) + off) + cl;
#pragma unroll
            for (int ai = 0; ai < 2; ++ai)
#pragma unroll
                for (int m = 0; m < 4; ++m) {
                    const int row = row0 + ai * HALF + m * 16;
#pragma unroll
                    for (int bj = 0; bj < 2; ++bj) {
                        f32x4 v0 = acc[ai][bj][m][0], v1 = acc[ai][bj][m][1];
                        if (act) {
#pragma unroll
                            for (int i = 0; i < 4; ++i) {
                                const float s0 = __builtin_amdgcn_rcpf(1.0f + __expf(-v0[i])), s1 = __builtin_amdgcn_rcpf(1.0f + __expf(-v1[i]));
                                v0[i] = act == 1 ? v0[i] * s0 : s0; v1[i] = act == 1 ? v1[i] * s1 : s1;
                            }
                        }
                        store8bf(base + (size_t)row * ld + bj * HALF, v0, v1);
                    }
                }
        }
    }
};
struct EpiScaleF32 {
    static constexpr bool PERM = true, AFTER_DRAIN = false;
    const bf16_t* G; float* Y;
    __device__ __forceinline__ void operator()(const f32x4 (&acc)[2][2][4][2], const Unit& u, int wr, int wc, int fr, int fq) const {
        const int row0 = u.pm * BM + wr * 64 + fr; const int col0 = u.pn * BM + wc * 32 + 8 * fq;
#pragma unroll
        for (int ai = 0; ai < 2; ++ai)
#pragma unroll
            for (int m = 0; m < 4; ++m) {
                const size_t ro = (size_t)(row0 + ai * HALF + m * 16) * 1024 + col0;
#pragma unroll
                for (int bj = 0; bj < 2; ++bj) {
                    f32x4 g0, g1; load8bf(G + ro + bj * HALF, g0, g1);
                    *(f32x4*)(Y + ro + bj * HALF) = acc[ai][bj][m][0] * g0; *(f32x4*)(Y + ro + bj * HALF + 4) = acc[ai][bj][m][1] * g1;
                }
            }
    }
};
struct EpiMerge {
    static constexpr bool PERM = true, AFTER_DRAIN = false;
    const bf16_t* G; const float* Y; bf16_t* O;
    __device__ __forceinline__ void operator()(const f32x4 (&acc)[2][2][4][2], const Unit& u, int wr, int wc, int fr, int fq) const {
        const int row0 = u.pm * BM + wr * 64 + fr; const int col0 = u.pn * BM + wc * 32 + 8 * fq;
#pragma unroll
        for (int ai = 0; ai < 2; ++ai)
#pragma unroll
            for (int m = 0; m < 4; ++m) {
                const size_t ro = (size_t)(row0 + ai * HALF + m * 16) * 1024 + col0;
#pragma unroll
                for (int bj = 0; bj < 2; ++bj) {
                    f32x4 g0, g1; load8bf(G + ro + bj * HALF, g0, g1);
                    const f32x4 y0 = *(const f32x4*)(Y + ro + bj * HALF), y1 = *(const f32x4*)(Y + ro + bj * HALF + 4);
                    store8bf(O + ro + bj * HALF, y0 + acc[ai][bj][m][0] * g0, y1 + acc[ai][bj][m][1] * g1);
                }
            }
    }
};
struct EpiOut {
    static constexpr bool PERM = true, AFTER_DRAIN = false;
    const float* X; float* O; float* SS;
    __device__ __forceinline__ void operator()(const f32x4 (&acc)[2][2][4][2], const Unit& u, int wr, int wc, int fr, int fq) const {
        const int row0 = u.pm * BM + wr * 64 + fr; const int col0 = u.pn * BM + wc * 32 + 8 * fq;
#pragma unroll
        for (int ai = 0; ai < 2; ++ai)
#pragma unroll
            for (int m = 0; m < 4; ++m) {
                const int row = row0 + ai * HALF + m * 16; const size_t ro = (size_t)row * 1024 + col0; float ss = 0.f;
#pragma unroll
                for (int bj = 0; bj < 2; ++bj) {
                    const f32x4 x0 = *(const f32x4*)(X + ro + bj * HALF), x1 = *(const f32x4*)(X + ro + bj * HALF + 4);
                    const f32x4 o0 = x0 + acc[ai][bj][m][0], o1 = x1 + acc[ai][bj][m][1];
                    *(f32x4*)(O + ro + bj * HALF) = o0; *(f32x4*)(O + ro + bj * HALF + 4) = o1;
                    ss += (o0[0] * o0[0] + o0[1] * o0[1]) + (o0[2] * o0[2] + o0[3] * o0[3]) + (o1[0] * o1[0] + o1[1] * o1[1]) + (o1[2] * o1[2] + o1[3] * o1[3]);
                }
                ss += __shfl_xor(ss, 16); ss += __shfl_xor(ss, 32);
                if (fq == 0) atomicAdd(SS + row, ss);
            }
    }
};

struct EpiOutNorm {
    static constexpr bool PERM = true, AFTER_DRAIN = true;
    const float* X; float* O; float* SS; unsigned* cnt; const float* fw;
    __device__ __forceinline__ void fused(f32x4 (&acc)[2][2][4][2], const Unit& u, int wr, int wc, int fr, int fq, PG8_LAS unsigned char* lds, int wid, int lane) const {
        const int row0 = u.pm * BM + wr * 64 + fr; const int col0 = u.pn * BM + wc * 32 + 8 * fq;
#pragma unroll
        for (int ai = 0; ai < 2; ++ai)
#pragma unroll
            for (int m = 0; m < 4; ++m) {
                const int row = row0 + ai * HALF + m * 16; const size_t ro = (size_t)row * 1024 + col0; float ss = 0.f;
#pragma unroll
                for (int bj = 0; bj < 2; ++bj) {
                    const f32x4 x0 = *(const f32x4*)(X + ro + bj * HALF), x1 = *(const f32x4*)(X + ro + bj * HALF + 4);
                    const f32x4 o0 = x0 + acc[ai][bj][m][0], o1 = x1 + acc[ai][bj][m][1];
                    acc[ai][bj][m][0] = o0; acc[ai][bj][m][1] = o1;
                    ss += (o0[0] * o0[0] + o0[1] * o0[1]) + (o0[2] * o0[2] + o0[3] * o0[3]) + (o1[0] * o1[0] + o1[1] * o1[1]) + (o1[2] * o1[2] + o1[3] * o1[3]);
                }
                ss += __shfl_xor(ss, 16); ss += __shfl_xor(ss, 32);
                if (fq == 0) __hip_atomic_fetch_add(SS + row, ss, __ATOMIC_RELAXED, __HIP_MEMORY_SCOPE_AGENT);
            }
        asm volatile("s_waitcnt vmcnt(0)" ::: "memory");
        __syncthreads();
        if (threadIdx.x == 0) {
            unsigned* c = cnt + 64 * u.pm;
            __hip_atomic_fetch_add(c, 1u, __ATOMIC_RELAXED, __HIP_MEMORY_SCOPE_AGENT);
            unsigned sp = 0;
            while (__hip_atomic_load(c, __ATOMIC_RELAXED, __HIP_MEMORY_SCOPE_AGENT) < 4u) { __builtin_amdgcn_s_sleep(2); if (++sp > (1u << 22)) break; }
        }
        __syncthreads();
        f32x4 w0[2], w1[2];
#pragma unroll
        for (int bj = 0; bj < 2; ++bj) { w0[bj] = *(const f32x4*)(fw + col0 + bj * HALF); w1[bj] = *(const f32x4*)(fw + col0 + bj * HALF + 4); }
#pragma unroll
        for (int ai = 0; ai < 2; ++ai)
#pragma unroll
            for (int m = 0; m < 4; ++m) {
                const int row = row0 + ai * HALF + m * 16; const size_t ro = (size_t)row * 1024 + col0;
                const float rstd = 1.0f / sqrtf(__hip_atomic_load(SS + row, __ATOMIC_RELAXED, __HIP_MEMORY_SCOPE_AGENT) * (1.0f / 1024.0f) + 1e-5f);
#pragma unroll
                for (int bj = 0; bj < 2; ++bj) {
                    *(f32x4*)(O + ro + bj * HALF) = acc[ai][bj][m][0] * rstd * w0[bj]; *(f32x4*)(O + ro + bj * HALF + 4) = acc[ai][bj][m][1] * rstd * w1[bj];
                }
            }
    }
};

struct EpiMerge2 {
    static constexpr bool PERM = true, AFTER_DRAIN = false;
    const bf16_t* GA; const bf16_t* GB; bf16_t* O;
    __device__ __forceinline__ void mid(f32x4 (&acc)[2][2][4][2], const Unit& u, int wr, int wc, int fr, int fq) const {
        const int row0 = u.pm * BM + wr * 64 + fr; const int col0 = u.pn * BM + wc * 32 + 8 * fq;
#pragma unroll
        for (int ai = 0; ai < 2; ++ai)
#pragma unroll
            for (int m = 0; m < 4; ++m) {
                const size_t ro = (size_t)(row0 + ai * HALF + m * 16) * 1024 + col0;
#pragma unroll
                for (int bj = 0; bj < 2; ++bj) {
                    f32x4 a0, a1, b0, b1; load8bf(GA + ro + bj * HALF, a0, a1); load8bf(GB + ro + bj * HALF, b0, b1);
#pragma unroll
                    for (int i = 0; i < 4; ++i) { acc[ai][bj][m][0][i] *= a0[i] * __builtin_amdgcn_rcpf(fmaxf(b0[i], 1e-30f)); acc[ai][bj][m][1][i] *= a1[i] * __builtin_amdgcn_rcpf(fmaxf(b1[i], 1e-30f)); }
                }
                asm volatile("" : "+v"(acc[ai][0][m][0]), "+v"(acc[ai][0][m][1]), "+v"(acc[ai][1][m][0]), "+v"(acc[ai][1][m][1]));
                if (m & 1) asm volatile("" ::: "memory");
            }
    }
    __device__ __forceinline__ void operator()(const f32x4 (&acc)[2][2][4][2], const Unit& u, int wr, int wc, int fr, int fq) const {
        if (u.seg == 0) { mid(const_cast<f32x4 (&)[2][2][4][2]>(acc), u, wr, wc, fr, fq); return; }
        const int row0 = u.pm * BM + wr * 64 + fr; const int col0 = u.pn * BM + wc * 32 + 8 * fq;
#pragma unroll
        for (int ai = 0; ai < 2; ++ai)
#pragma unroll
            for (int m = 0; m < 4; ++m) {
                const size_t ro = (size_t)(row0 + ai * HALF + m * 16) * 1024 + col0;
#pragma unroll
                for (int bj = 0; bj < 2; ++bj) {
                    f32x4 g0, g1; load8bf(GB + ro + bj * HALF, g0, g1);
                    store8bf(O + ro + bj * HALF, acc[ai][bj][m][0] * g0, acc[ai][bj][m][1] * g1);
                }
            }
    }
};
template <class Epi, class Sched, bool ALIGN_EPI = false, bool SP2 = false, bool MID = false>
__device__ __forceinline__ void gemm_phase(PG8_LAS unsigned char* lds, const Gemm g, const Sched& S, const Epi& E) {
    const int tid = threadIdx.x, wid = __builtin_amdgcn_readfirstlane(tid >> 6), lane = tid & 63, wr = wid >> 2, wc = wid & 3, fr = lane & 15, fq = lane >> 4;
    const int K = g.ld, nt = g.K / BK;
    const size_t segb = (size_t)g.K * 2;
    unsigned voffA[2], voffB[2];
#pragma unroll
    for (int i = 0; i < 2; ++i) { int R, C; stage_rc(tid * 16 + i * 8192, R, C); const int Rb = Epi::PERM ? ((R & ~31) + perm32(R & 31)) : R;
        voffA[i] = (unsigned)(R * K + C) * 2u; voffB[i] = (unsigned)(Rb * K + C) * 2u; }
    const size_t kstep = (size_t)(BK * 2);
    const size_t hstep = (size_t)HALF * K * 2;
    const size_t tstep = 2 * hstep;
    const unsigned ldsw = (unsigned)wid * 1024u;
    const int aoff = lds_byte(wr * 64 + fr, fq * 8), boff = lds_byte(wc * 32 + fr, fq * 8);
#define PG8_SA(b, h) (((b) * 2 + (h)) * HTB)
#define PG8_SB(b, h) ((4 + (b) * 2 + (h)) * HTB)
#define PG8_STAGE(bufoff, gbase, voff) do { _Pragma("unroll") for (int _i = 0; _i < 2; ++_i) \
        __builtin_amdgcn_global_load_lds((const unsigned*)((const char*)(gbase) + (voff)[_i]), (PG8_LAS unsigned*)(lds + (bufoff) + ldsw + _i * 8192), 16, 0, 0); } while (0)
#define PG8_LDA(dst, b, h) do { _Pragma("unroll") for (int m = 0; m < 4; ++m) _Pragma("unroll") for (int k = 0; k < 2; ++k) dst[m][k] = *(const PG8_LAS bf16x8*)(lds + PG8_SA(b, h) + aoff + m * 2048 + k * 1024); } while (0)
#define PG8_LDB(dst, b, h) do { _Pragma("unroll") for (int n = 0; n < 2; ++n) _Pragma("unroll") for (int k = 0; k < 2; ++k) dst[n][k] = *(const PG8_LAS bf16x8*)(lds + PG8_SB(b, h) + boff + n * 2048 + k * 1024); } while (0)
#define PG8_MMA(ai, bj, At, Bt) do { __builtin_amdgcn_s_setprio(1); _Pragma("unroll") for (int m = 0; m < 4; ++m) _Pragma("unroll") for (int n = 0; n < 2; ++n) _Pragma("unroll") for (int k = 0; k < 2; ++k) \
        acc[ai][bj][m][n] = __builtin_amdgcn_mfma_f32_16x16x32_bf16(Bt[n][k], At[m][k], acc[ai][bj][m][n], 0, 0, 0); __builtin_amdgcn_s_setprio(0); } while (0)
#define PG8_WAIT_V(n) asm volatile("s_waitcnt vmcnt(" #n ")" ::: "memory")
#define PG8_WAIT_L(n) asm volatile("s_waitcnt lgkmcnt(" #n ")" ::: "memory")
#define PG8_BAR __builtin_amdgcn_s_barrier()
#define PG8_SCHED __builtin_amdgcn_sched_barrier(0)
    Unit cur, nxt; int ui = 0;
    if (!S.next(0, cur)) return;
    f32x4 acc[2][2][4][2];
#pragma unroll
    for (int a = 0; a < 2; ++a)
#pragma unroll
        for (int b = 0; b < 2; ++b)
#pragma unroll
            for (int m = 0; m < 4; ++m)
#pragma unroll
                for (int n = 0; n < 2; ++n) acc[a][b][m][n] = (f32x4){0.f, 0.f, 0.f, 0.f};
    bf16x8 At[4][2], B0[2][2], B1[2][2];
    const char* cA = (const char*)g.A + (size_t)cur.pm * tstep + cur.seg * segb; const char* cB = (const char*)g.Bt + (size_t)cur.pn * tstep + cur.seg * segb;
    S.a_ready(cur);
    if constexpr (SP2) {
        PG8_STAGE(PG8_SB(0, 0), cB, voffB); PG8_STAGE(PG8_SB(0, 1), cB + hstep, voffB); PG8_STAGE(PG8_SA(0, 0), cA, voffA); PG8_STAGE(PG8_SA(0, 1), cA + hstep, voffA);
        if (wr == 1) PG8_BAR;
        PG8_WAIT_V(2); PG8_BAR;
        PG8_STAGE(PG8_SB(1, 0), cB + kstep, voffB); PG8_STAGE(PG8_SA(1, 0), cA + kstep, voffA); PG8_STAGE(PG8_SB(1, 1), cB + hstep + kstep, voffB);
        PG8_WAIT_V(6); PG8_BAR;
    } else {
        PG8_STAGE(PG8_SB(0, 0), cB, voffB); PG8_STAGE(PG8_SA(0, 0), cA, voffA); PG8_STAGE(PG8_SB(0, 1), cB + hstep, voffB); PG8_STAGE(PG8_SA(0, 1), cA + hstep, voffA);
        if (wr == 1) PG8_BAR;
        PG8_WAIT_V(4); PG8_BAR;
        PG8_STAGE(PG8_SB(1, 0), cB + kstep, voffB); PG8_STAGE(PG8_SA(1, 0), cA + kstep, voffA); PG8_STAGE(PG8_SB(1, 1), cB + hstep + kstep, voffB);
        PG8_WAIT_V(6); PG8_BAR;
    }
    for (;;) {
        const bool has_next = S.next(ui + 1, nxt);
        const char* nA = has_next ? (const char*)g.A + (size_t)nxt.pm * tstep + nxt.seg * segb : cA; const char* nB = has_next ? (const char*)g.Bt + (size_t)nxt.pn * tstep + nxt.seg * segb : cB;
        for (int t = 0; t < nt; t += 2) {
            const bool last = (t == nt - 2);
            const char* a1 = cA + (size_t)(t + 1) * kstep;
            const char* a2 = last ? nA : cA + (size_t)(t + 2) * kstep; const char* b2 = last ? nB : cB + (size_t)(t + 2) * kstep;
            const char* a3 = a2 + kstep; const char* b3 = b2 + kstep;
            if (last && has_next) S.a_ready(nxt);
            if constexpr (SP2) {
            PG8_LDB(B0, 0, 0); PG8_LDB(B1, 0, 1); PG8_SCHED; PG8_LDA(At, 0, 0); PG8_STAGE(PG8_SA(1, 1), a1 + hstep, voffA);
            PG8_WAIT_V(8); PG8_WAIT_L(0); PG8_BAR; PG8_MMA(0, 0, At, B0); PG8_MMA(0, 1, At, B1); PG8_BAR; PG8_SCHED;
            PG8_LDA(At, 0, 1); PG8_STAGE(PG8_SB(0, 0), b2, voffB); PG8_STAGE(PG8_SB(0, 1), b2 + hstep, voffB); PG8_STAGE(PG8_SA(0, 0), a2, voffA);
            PG8_WAIT_V(8); PG8_WAIT_L(0); PG8_BAR; PG8_MMA(1, 0, At, B0); PG8_MMA(1, 1, At, B1); PG8_BAR; PG8_SCHED;
            PG8_LDB(B0, 1, 0); PG8_LDB(B1, 1, 1); PG8_SCHED; PG8_LDA(At, 1, 0); PG8_STAGE(PG8_SA(0, 1), a2 + hstep, voffA);
            PG8_WAIT_V(8); PG8_WAIT_L(0); PG8_BAR; PG8_MMA(0, 0, At, B0); PG8_MMA(0, 1, At, B1); PG8_BAR; PG8_SCHED;
            PG8_LDA(At, 1, 1); PG8_STAGE(PG8_SB(1, 0), b3, voffB); PG8_STAGE(PG8_SB(1, 1), b3 + hstep, voffB); PG8_STAGE(PG8_SA(1, 0), a3, voffA);
            PG8_WAIT_V(8); PG8_WAIT_L(0); PG8_BAR; PG8_MMA(1, 0, At, B0); PG8_MMA(1, 1, At, B1); PG8_BAR; PG8_SCHED;
            } else {
            PG8_LDB(B0, 0, 0); PG8_SCHED; PG8_LDA(At, 0, 0); PG8_STAGE(PG8_SA(1, 1), a1 + hstep, voffA);
            PG8_WAIT_L(8); PG8_BAR; PG8_WAIT_L(0); PG8_MMA(0, 0, At, B0); PG8_BAR; PG8_SCHED;
            PG8_LDB(B1, 0, 1); PG8_STAGE(PG8_SB(0, 0), b2, voffB);
            PG8_BAR; PG8_WAIT_L(0); PG8_MMA(0, 1, At, B1); PG8_BAR;
            PG8_LDA(At, 0, 1); PG8_STAGE(PG8_SA(0, 0), a2, voffA);
            PG8_BAR; PG8_WAIT_L(0); PG8_MMA(1, 0, At, B0); PG8_BAR; PG8_SCHED;
            PG8_STAGE(PG8_SB(0, 1), b2 + hstep, voffB);
            PG8_WAIT_V(6); PG8_BAR; PG8_MMA(1, 1, At, B1); PG8_BAR;
            PG8_LDB(B0, 1, 0); PG8_SCHED; PG8_LDA(At, 1, 0); PG8_STAGE(PG8_SA(0, 1), a2 + hstep, voffA);
            PG8_WAIT_L(8); PG8_BAR; PG8_WAIT_L(0); PG8_MMA(0, 0, At, B0); PG8_BAR; PG8_SCHED;
            PG8_LDB(B1, 1, 1); PG8_STAGE(PG8_SB(1, 0), b3, voffB);
            PG8_BAR; PG8_WAIT_L(0); PG8_MMA(0, 1, At, B1); PG8_BAR;
            PG8_LDA(At, 1, 1); PG8_STAGE(PG8_SA(1, 0), a3, voffA);
            PG8_BAR; PG8_WAIT_L(0); PG8_MMA(1, 0, At, B0); PG8_BAR; PG8_SCHED;
            PG8_STAGE(PG8_SB(1, 1), b3 + hstep, voffB);
            PG8_WAIT_V(6); PG8_BAR; PG8_MMA(1, 1, At, B1); PG8_BAR;
            }
        }
        if constexpr (ALIGN_EPI) { if (wr == 0) PG8_BAR; }
        if constexpr (!Epi::AFTER_DRAIN) { E(acc, cur, wr, wc, fr, fq); S.done(cur); }
        if (!has_next) break;
        if (!(MID && cur.seg == 0))
#pragma unroll
        for (int a = 0; a < 2; ++a)
#pragma unroll
            for (int b = 0; b < 2; ++b)
#pragma unroll
                for (int m = 0; m < 4; ++m)
#pragma unroll
                    for (int n = 0; n < 2; ++n) acc[a][b][m][n] = (f32x4){0.f, 0.f, 0.f, 0.f};
        cur = nxt; cA = nA; cB = nB; ++ui;
        if constexpr (ALIGN_EPI) { if (wr == 1) PG8_BAR; }
    }
    PG8_WAIT_V(0);
    if constexpr (!ALIGN_EPI) { if (wr == 0) PG8_BAR; }
    PG8_BAR;
    if constexpr (Epi::AFTER_DRAIN) { E.fused(acc, cur, wr, wc, fr, fq, lds, wid, lane); S.done(cur); }
#undef PG8_SA
#undef PG8_SB
#undef PG8_STAGE
#undef PG8_LDA
#undef PG8_LDB
#undef PG8_MMA
#undef PG8_WAIT_V
#undef PG8_WAIT_L
#undef PG8_BAR
#undef PG8_SCHED
}
}
#define GAS __attribute__((address_space(1)))
#define LAS __attribute__((address_space(3)))
typedef unsigned short bf16;
typedef unsigned v4u __attribute__((ext_vector_type(4)));
typedef float f32x4 __attribute__((ext_vector_type(4)));
typedef short bf16x8 __attribute__((ext_vector_type(8)));
typedef GAS unsigned gu32;
typedef GAS unsigned long long gu64;
#define RLX_AGENT __ATOMIC_RELAXED, __HIP_MEMORY_SCOPE_AGENT
#define LDS_WAIT() asm volatile("s_waitcnt lgkmcnt(0)" ::: "memory")
#define VM_WAIT() asm volatile("s_waitcnt vmcnt(0)" ::: "memory")
__device__ __forceinline__ unsigned long long rt() { return __builtin_amdgcn_s_memrealtime(); }
__device__ __forceinline__ unsigned f2bf(float f) { unsigned u = __builtin_bit_cast(unsigned, f); return (u + 0x7fffu + ((u >> 16) & 1u)) >> 16; }
__device__ __forceinline__ unsigned pk2(float lo, float hi) { return f2bf(lo) | (f2bf(hi) << 16); }

#define XB_TMO      128
#define XB_XCNT(j)  (256  + 64 * (j))
#define XB_XSUB(j)  (1280 + 64 * (j))
#define XB_XGEN(j)  (2304 + 64 * (j))
#define XB_TOP      3328
#define XB_TOPGEN   3392
#define XCD_BAR_WORDS 3456
#define XB_SPIN_CAP (1u << 18)

__device__ __forceinline__ unsigned xb_ld(unsigned* p)              { return __hip_atomic_load(p, __ATOMIC_RELAXED, __HIP_MEMORY_SCOPE_AGENT); }
__device__ __forceinline__ unsigned xb_add(unsigned* p, unsigned v) { return __hip_atomic_fetch_add(p, v, __ATOMIC_RELAXED, __HIP_MEMORY_SCOPE_AGENT); }
__device__ __forceinline__ unsigned xb_xcc_id() { return (unsigned)__builtin_amdgcn_s_getreg((3 << 11) | 20) & 0xFu; }
#define XB_SPIN(cond, bar) do { unsigned _sp = 0; while (cond) { __builtin_amdgcn_s_sleep(1); \
    if ((++_sp & 255u) == 0u) { if (xb_ld(&(bar)[XB_TMO])) break; if (_sp > XB_SPIN_CAP) { atomicAdd(&(bar)[XB_TMO], 1u); break; } } } } while (0)

struct XcdBarrier {
    unsigned* bar; unsigned x;
    volatile LAS unsigned* st;
};

__device__ __forceinline__ XcdBarrier xcd_barrier_post(unsigned* bar, volatile LAS unsigned* st) {
    XcdBarrier b; b.bar = bar; b.x = xb_xcc_id(); b.st = st;
    if (threadIdx.x == 0) (void)xb_add(&bar[XB_XCNT(b.x)], 1u);
    return b;
}
__device__ __forceinline__ void xcd_barrier_complete(unsigned* bar, unsigned x, unsigned& nloc, unsigned& nx) {
    const unsigned G = gridDim.x * gridDim.y * gridDim.z;
    unsigned sum, cnt, mine, sp = 0u;
    for (;;) {
        sum = 0u; cnt = 0u; mine = 0u;
#pragma unroll
        for (unsigned j = 0; j < 16; ++j) { const unsigned c = xb_ld(&bar[XB_XCNT(j)]); sum += c; cnt += (c > 0u) ? 1u : 0u; mine = (j == x) ? c : mine; }
        if (sum == G) break;
        __builtin_amdgcn_s_sleep(1);
        if ((++sp & 255u) == 0u) { if (xb_ld(&bar[XB_TMO])) break; if (sp > XB_SPIN_CAP) { atomicAdd(&bar[XB_TMO], 1u); break; } }
    }
    nloc = mine > 0u ? mine : 1u; nx = cnt > 0u ? cnt : 1u;
}

__device__ __forceinline__ void xcd_barrier(const XcdBarrier& b) {
    asm volatile("s_waitcnt vmcnt(0)" ::: "memory");
    __syncthreads();
    if (threadIdx.x == 0) {
        unsigned* bar = b.bar;
        __builtin_amdgcn_s_waitcnt(0);
        unsigned nloc = b.st[0], nx = b.st[1];
        if (nloc == 0u) { xcd_barrier_complete(bar, b.x, nloc, nx); b.st[0] = nloc; b.st[1] = nx; }
        const unsigned old = xb_add(&bar[XB_XSUB(b.x)], 1u);
        const unsigned gen = old / nloc;
        if (old + 1u == (gen + 1u) * nloc) {
            __builtin_amdgcn_fence(__ATOMIC_RELEASE, "agent");
            asm volatile("s_waitcnt vmcnt(0)" ::: "memory");
            const unsigned og = xb_add(&bar[XB_TOP], 1u);
            const unsigned tg = og / nx;
            if (og + 1u == (tg + 1u) * nx) xb_add(&bar[XB_TOPGEN], 1u);
            else XB_SPIN(xb_ld(&bar[XB_TOPGEN]) == tg, bar);
            __builtin_amdgcn_fence(__ATOMIC_ACQUIRE, "agent");
            xb_add(&bar[XB_XGEN(b.x)], 1u);
            asm volatile("s_waitcnt vmcnt(0)" ::: "memory");
        } else {
            XB_SPIN(xb_ld(&bar[XB_XGEN(b.x)]) == gen, bar);
            __builtin_amdgcn_fence(__ATOMIC_ACQUIRE, "agent");
            asm volatile("s_waitcnt vmcnt(0)" ::: "memory");
        }
    }
    __syncthreads();
}
typedef unsigned u32x4 __attribute__((ext_vector_type(4)));

constexpr int RING_OFF = 0, RING_BYTES = 147456;
constexpr int LDSCTL_OFF = RING_BYTES, MISC_OFF = LDSCTL_OFF + 320;
constexpr int LDS_BYTES = RING_BYTES + 1024;

struct Frame {
    LAS unsigned char* lds;
    volatile LAS unsigned* MISC;
    int tid, lane, wave, vcu, G;
};

__device__ __forceinline__ float wave_sum(float v) {
#pragma unroll
    for (int o = 1; o < 64; o <<= 1) v += __shfl_xor(v, o);
    return v;
}
__device__ __forceinline__ int src_col_w1(int n) {
    if (n < 1152) { const int hh = n >> 6, p = n & 63; return hh * 64 + 4 * (p >> 3) + (p & 3) + 32 * ((p >> 2) & 1); }
    if (n < 5376) return n;
    return n + 16;
}
__device__ __forceinline__ void p0_transpose_item(const float* W, int ldw, int K, bf16* WT, int n0, int k0, int srccol, LAS float* scr, int lane) {
    float tv[32];
#pragma unroll
    for (int i = 0; i < 32; ++i) { const int kk = 2 * i + (lane >> 5); tv[i] = W[(size_t)(k0 + kk) * ldw + srccol]; }
#pragma unroll
    for (int i = 0; i < 32; ++i) { const int kk = 2 * i + (lane >> 5); scr[kk * 33 + (lane & 31)] = tv[i]; }
    LDS_WAIT(); asm volatile("" ::: "memory");
    const int c = lane & 7;
#pragma unroll
    for (int j = 0; j < 4; ++j) { const int n = (lane >> 3) + 8 * j; const LAS float* s = scr + (8 * c) * 33 + n;
        v4u o; o.x = pk2(s[0 * 33], s[1 * 33]); o.y = pk2(s[2 * 33], s[3 * 33]); o.z = pk2(s[4 * 33], s[5 * 33]); o.w = pk2(s[6 * 33], s[7 * 33]);
        *(GAS v4u*)(WT + (size_t)(n0 + n) * K + k0 + 8 * c) = o; }
    LDS_WAIT(); asm volatile("" ::: "memory");
}
__device__ __forceinline__ void p0_fold_item(const float* W, const float* up, bf16* WT, int e0, int k0, LAS float* scr, int lane) {
    float u[16];
#pragma unroll
    for (int r = 0; r < 16; ++r) u[r] = up[r * 512 + e0 + (lane & 31)];
#pragma unroll 4
    for (int i = 0; i < 32; ++i) { const int kk = 2 * i + (lane >> 5); const float* wr = W + (size_t)(k0 + kk) * INW + 5376; float a = 0.f;
#pragma unroll
        for (int r = 0; r < 16; ++r) a = fmaf(wr[r], u[r], a);
        scr[kk * 33 + (lane & 31)] = a; }
    LDS_WAIT(); asm volatile("" ::: "memory");
    const int c = lane & 7;
#pragma unroll
    for (int j = 0; j < 4; ++j) { const int n = (lane >> 3) + 8 * j; const LAS float* s = scr + (8 * c) * 33 + n;
        v4u o; o.x = pk2(s[0 * 33], s[1 * 33]); o.y = pk2(s[2 * 33], s[3 * 33]); o.z = pk2(s[4 * 33], s[5 * 33]); o.w = pk2(s[6 * 33], s[7 * 33]);
        *(GAS v4u*)(WT + (size_t)(7424 + e0 + n) * 1024 + k0 + 8 * c) = o; }
    LDS_WAIT(); asm volatile("" ::: "memory");
}
__device__ __forceinline__ void rms_row_to_bf16(int lane, const float* xrow, const float* w, bf16* orow) {
    const GAS f32x4* xr = (const GAS f32x4*)xrow + lane; const GAS f32x4* wr = (const GAS f32x4*)w + lane;
    f32x4 v[4]; float s = 0.f;
#pragma unroll
    for (int j = 0; j < 4; ++j) { v[j] = xr[64 * j]; s += (v[j].x * v[j].x + v[j].y * v[j].y) + (v[j].z * v[j].z + v[j].w * v[j].w); }
    const float rstd = 1.f / sqrtf(wave_sum(s) * (1.f / D) + EPS);
    GAS unsigned long long* o8 = (GAS unsigned long long*)orow + lane;
#pragma unroll
    for (int j = 0; j < 4; ++j) { const f32x4 ww = wr[64 * j];
        o8[64 * j] = (unsigned long long)pk2(v[j].x * rstd * ww.x, v[j].y * rstd * ww.y) | ((unsigned long long)pk2(v[j].z * rstd * ww.z, v[j].w * rstd * ww.w) << 32); }
}

__device__ __forceinline__ void rms_rows4_to_bf16(int lane, const float* x, const float* w, bf16* out, int m0, int stride) {
    f32x4 v[4][4]; float s[4];
#pragma unroll
    for (int r = 0; r < 4; ++r) { const int m = m0 + r * stride; const GAS f32x4* xr = (const GAS f32x4*)(x + (size_t)(m < M ? m : m0) * D) + lane;
#pragma unroll
        for (int j = 0; j < 4; ++j) v[r][j] = xr[64 * j]; }
    const GAS f32x4* wr = (const GAS f32x4*)w + lane;
    f32x4 ww[4];
#pragma unroll
    for (int j = 0; j < 4; ++j) ww[j] = wr[64 * j];
#pragma unroll
    for (int r = 0; r < 4; ++r) { float a = 0.f;
#pragma unroll
        for (int j = 0; j < 4; ++j) a += (v[r][j].x * v[r][j].x + v[r][j].y * v[r][j].y) + (v[r][j].z * v[r][j].z + v[r][j].w * v[r][j].w);
        s[r] = a; }
#pragma unroll
    for (int o = 1; o < 64; o <<= 1) {
#pragma unroll
        for (int r = 0; r < 4; ++r) s[r] += __shfl_xor(s[r], o); }
#pragma unroll
    for (int r = 0; r < 4; ++r) { const int m = m0 + r * stride; if (m < M) { const float rstd = 1.f / sqrtf(s[r] * (1.f / D) + EPS);
        GAS unsigned long long* o8 = (GAS unsigned long long*)(out + (size_t)m * D) + lane;
#pragma unroll
        for (int j = 0; j < 4; ++j) o8[64 * j] = (unsigned long long)pk2(v[r][j].x * rstd * ww[j].x, v[r][j].y * rstd * ww[j].y) | ((unsigned long long)pk2(v[r][j].z * rstd * ww[j].z, v[r][j].w * rstd * ww[j].w) << 32); } }
}
typedef float f32x16 __attribute__((ext_vector_type(16)));
typedef short s16x4 __attribute__((ext_vector_type(4)));
typedef unsigned u32x2 __attribute__((ext_vector_type(2)));
__device__ __forceinline__ int crow(int r, int hi) { return (r & 3) + 8 * (r >> 2) + 4 * hi; }
constexpr int AT_KSTR = 144, AT_VSTR = 520, AT_K = 0, AT_V = 256 * AT_KSTR, AT_W = AT_V + 64 * AT_VSTR, AT_WB = 2 * 32 * 144;
static_assert(AT_W + 8 * AT_WB <= RING_BYTES && (AT_W % 16) == 0, "attention LDS");
__device__ __forceinline__ void attn_unit(LAS unsigned char* lds, int b, int nb, int g, const bf16* Q, const bf16* KV, bf16* AGO, const float* sinks) {
    const int tid = threadIdx.x, lane = tid & 63, r32 = lane & 31, hi = lane >> 5; const int wid = __builtin_amdgcn_readfirstlane(tid >> 6);
    const long tok0 = (long)b * T + nb * 128, key0 = tok0 - 128;
    const int jlo = nb > 0 ? 0 : 128;
#pragma unroll
    for (int i = 0; i < 4; ++i) { const int p = tid + 512 * i, key = p >> 3, ch = p & 7;
        if (key >= jlo) { const v4u v = *(const GAS v4u*)(KV + (key0 + key) * 256 + g * 64 + ch * 8); *(LAS v4u*)(lds + AT_K + key * AT_KSTR + ch * 16) = v; } }
#pragma unroll
    for (int i = 0; i < 4; ++i) { const int p = tid + 512 * i, key = p & 255, ch = p >> 8;
        if (key >= jlo) { const v4u v = *(const GAS v4u*)(KV + (key0 + key) * 256 + 128 + g * 64 + ch * 8);
            LAS unsigned short* vt = (LAS unsigned short*)(lds + AT_V + (ch * 8) * AT_VSTR + key * 2);
            vt[0 * (AT_VSTR / 2)] = (unsigned short)(v.x & 0xffff); vt[1 * (AT_VSTR / 2)] = (unsigned short)(v.x >> 16);
            vt[2 * (AT_VSTR / 2)] = (unsigned short)(v.y & 0xffff); vt[3 * (AT_VSTR / 2)] = (unsigned short)(v.y >> 16);
            vt[4 * (AT_VSTR / 2)] = (unsigned short)(v.z & 0xffff); vt[5 * (AT_VSTR / 2)] = (unsigned short)(v.z >> 16);
            vt[6 * (AT_VSTR / 2)] = (unsigned short)(v.w & 0xffff); vt[7 * (AT_VSTR / 2)] = (unsigned short)(v.w >> 16); } }
    __syncthreads();
    const int hq = g * 8 + wid; const float sink2 = sinks[hq] * 1.4426950408889634f;
    const float NEG = -INFINITY;
    LAS unsigned char* wq = lds + AT_W + wid * AT_WB; LAS unsigned char* wg = wq + 32 * 144;
    const int srow = lane >> 3, spc = lane & 7;
    u32x4 qn[4], gn[4];
#pragma unroll
    for (int j = 0; j < 4; ++j) { const long rq = (tok0 + 8 * j + srow) * 1024 + hq * 64 + spc * 8, rg = (tok0 + 8 * j + srow) * 2048 + hq * 64 + spc * 8; qn[j] = *(const GAS u32x4*)(Q + rq); gn[j] = *(const GAS u32x4*)(AGO + rg); }
    for (int R = 0; R < 4; ++R) {
        const long qtok = tok0 + 32 * R + r32;
#pragma unroll
        for (int j = 0; j < 4; ++j) { *(LAS u32x4*)(wq + (8 * j + srow) * 144 + spc * 16) = qn[j]; *(LAS u32x4*)(wg + (8 * j + srow) * 144 + spc * 16) = gn[j]; }
        if (R < 3) {
#pragma unroll
            for (int j = 0; j < 4; ++j) { const long rq = (tok0 + 32 * (R + 1) + 8 * j + srow) * 1024 + hq * 64 + spc * 8, rg = (tok0 + 32 * (R + 1) + 8 * j + srow) * 2048 + hq * 64 + spc * 8; qn[j] = *(const GAS u32x4*)(Q + rq); gn[j] = *(const GAS u32x4*)(AGO + rg); }
        }
        bf16x8 qf[4];
#pragma unroll
        for (int s = 0; s < 4; ++s) qf[s] = *(const LAS bf16x8*)(wq + r32 * 144 + (16 * s + 8 * hi) * 2);
        f32x16 st[5];
#pragma unroll
        for (int tt = 0; tt < 5; ++tt) {
            const int Tt = R + tt; const bool active = (nb > 0) || (Tt >= 4);
#pragma unroll
            for (int r = 0; r < 16; ++r) st[tt][r] = 0.f;
            if (active) {
                bf16x8 kf4[4];
#pragma unroll
                for (int s = 0; s < 4; ++s) kf4[s] = *(const LAS bf16x8*)(lds + AT_K + (32 * Tt + r32) * AT_KSTR + (16 * s + 8 * hi) * 2);
                __builtin_amdgcn_s_setprio(1);
#pragma unroll
                for (int s = 0; s < 4; ++s) st[tt] = __builtin_amdgcn_mfma_f32_32x32x16_bf16(kf4[s], qf[s], st[tt], 0, 0, 0);
                __builtin_amdgcn_s_setprio(0);
            } else {
#pragma unroll
                for (int r = 0; r < 16; ++r) st[tt][r] = NEG;
            }
        }
#pragma unroll
        for (int r = 0; r < 16; ++r) { const int cr = crow(r, hi); if (!(cr > r32)) st[0][r] = NEG; if (!(cr <= r32)) st[4][r] = NEG; }
        float mx = sink2;
#pragma unroll
        for (int tt = 0; tt < 5; ++tt)
#pragma unroll
            for (int r = 0; r < 16; ++r) mx = fmaxf(mx, st[tt][r]);
        mx = fmaxf(mx, __shfl_xor(mx, 32));
        float l = 0.f;
#pragma unroll
        for (int tt = 0; tt < 5; ++tt)
#pragma unroll
            for (int r = 0; r < 16; ++r) { const float p = __builtin_amdgcn_exp2f(st[tt][r] - mx); st[tt][r] = p; l += p; }
        l += __shfl_xor(l, 32); l += __builtin_amdgcn_exp2f(sink2 - mx);
        const float inv_l = 1.0f / l;
        f32x16 o[2];
#pragma unroll
        for (int r = 0; r < 16; ++r) { o[0][r] = 0.f; o[1][r] = 0.f; }
#pragma unroll
        for (int tt = 0; tt < 5; ++tt) {
            const int Tt = R + tt; const bool active = (nb > 0) || (Tt >= 4);
            if (active) {
#pragma unroll
                for (int s = 0; s < 2; ++s) {
                    u32x4 pw; pw.x = pg8::cvt_pk_bf16(st[tt][8 * s + 0], st[tt][8 * s + 1]); pw.y = pg8::cvt_pk_bf16(st[tt][8 * s + 2], st[tt][8 * s + 3]);
                    pw.z = pg8::cvt_pk_bf16(st[tt][8 * s + 4], st[tt][8 * s + 5]); pw.w = pg8::cvt_pk_bf16(st[tt][8 * s + 6], st[tt][8 * s + 7]);
                    const bf16x8 pf = __builtin_bit_cast(bf16x8, pw);
#pragma unroll
                    for (int db = 0; db < 2; ++db) {
                        const LAS unsigned char* vp = lds + AT_V + (32 * db + r32) * AT_VSTR + (32 * Tt + 16 * s + 4 * hi) * 2;
                        const u32x2 a0 = *(const LAS u32x2*)vp, a1 = *(const LAS u32x2*)(vp + 16);
                        const u32x4 aw = (u32x4){a0.x, a0.y, a1.x, a1.y};
                        o[db] = __builtin_amdgcn_mfma_f32_32x32x16_bf16(__builtin_bit_cast(bf16x8, aw), pf, o[db], 0, 0, 0);
                    }
                }
            }
        }
#pragma unroll
        for (int db = 0; db < 2; ++db)
#pragma unroll
            for (int g4 = 0; g4 < 4; ++g4) {
                LAS u32x2* p = (LAS u32x2*)(wg + r32 * 144 + (32 * db + 8 * g4 + 4 * hi) * 2);
                const u32x2 gw = *p;
                u32x2 ow; ow.x = pg8::cvt_pk_bf16(o[db][4 * g4 + 0] * inv_l * pg8::bf_lo(gw.x), o[db][4 * g4 + 1] * inv_l * pg8::bf_hi(gw.x));
                ow.y = pg8::cvt_pk_bf16(o[db][4 * g4 + 2] * inv_l * pg8::bf_lo(gw.y), o[db][4 * g4 + 3] * inv_l * pg8::bf_hi(gw.y));
                *p = ow;
            }
#pragma unroll
        for (int j = 0; j < 4; ++j) { const u32x4 v = *(const LAS u32x4*)(wg + (8 * j + srow) * 144 + spc * 16);
            *(GAS u32x4*)(AGO + (tok0 + 32 * R + 8 * j + srow) * 2048 + hq * 64 + spc * 8) = v; }
    }
    __syncthreads();
}

typedef float f32x2 __attribute__((ext_vector_type(2)));
constexpr int G1_QSTR = 272;
constexpr int G1_QE = 0, G1_KE = G1_QE + 64 * G1_QSTR, G1_SEG = G1_KE + 64 * G1_QSTR, G1_END = G1_SEG + 4096;
struct PSet { f32x2 la2[8]; unsigned q2[8], k2[8]; };
__device__ __forceinline__ void pset_load(PSet& p, int b, int h, int n, int w, int c2, const bf16* BQ, const bf16* BK, const float* LOGA) {
    const long tk = (long)b * T + n * 64;
#pragma unroll
    for (int i = 0; i < 8; ++i) { const long ro = (tk + 8 * w + i) * 512 + h * 128 + 2 * c2;
        p.la2[i] = *(const GAS f32x2*)(LOGA + ro); p.q2[i] = *(const GAS unsigned*)(BQ + ro); p.k2[i] = *(const GAS unsigned*)(BK + ro); }
}
__device__ __forceinline__ void gla_pre_item(PSet& p, LAS unsigned char* lds, int bh, int n, bf16* BQ, bf16* BK, bf16* ATTG, float* DECG) {
    const int tid = threadIdx.x, lane = tid & 63, r32 = lane & 31, hi = lane >> 5; const int w = __builtin_amdgcn_readfirstlane(tid >> 6);
    const int b = bh >> 2, h = bh & 3, c2 = tid & 63;
    LAS f32x2* SEG = (LAS f32x2*)(lds + G1_SEG);
    const long tokc = (long)b * T + n * 64;
#pragma unroll
    for (int i = 1; i < 8; ++i) p.la2[i] += p.la2[i - 1];
    SEG[w * 64 + c2] = p.la2[7];
    __syncthreads();
    f32x2 off = (f32x2){0.f, 0.f}, bl = (f32x2){0.f, 0.f};
#pragma unroll
    for (int s = 0; s < 8; ++s) { const f32x2 v = SEG[s * 64 + c2]; bl += v; if (s < w) off += v; }
    const float decx = __expf(bl.x), decy = __expf(bl.y);
    if (w == 0) __hip_atomic_store((unsigned long long*)(DECG + ((long)bh * 32 + n) * 128 + 2 * c2), ((unsigned long long)__float_as_uint(decy) << 32) | __float_as_uint(decx), __ATOMIC_RELAXED, __HIP_MEMORY_SCOPE_AGENT);
#pragma unroll
    for (int i = 0; i < 8; ++i) {
        const float bx = off.x + p.la2[i].x, by = off.y + p.la2[i].y;
        const float ex = __expf(bx), ey = __expf(by), iex = __builtin_amdgcn_rcpf(ex), iey = __builtin_amdgcn_rcpf(ey);
        const float qx = pg8::bf_lo(p.q2[i]) * 0.08838834764831845f * ex, qy = pg8::bf_hi(p.q2[i]) * 0.08838834764831845f * ey;
        const float kx = pg8::bf_lo(p.k2[i]) * iex, ky = pg8::bf_hi(p.k2[i]) * iey;
        const unsigned qw = pg8::cvt_pk_bf16(qx, qy);
        const long ro = (tokc + 8 * w + i) * 512 + h * 128 + 2 * c2;
        *(LAS unsigned*)(lds + G1_QE + (8 * w + i) * G1_QSTR + c2 * 4) = qw;
        *(LAS unsigned*)(lds + G1_KE + (8 * w + i) * G1_QSTR + c2 * 4) = pg8::cvt_pk_bf16(kx, ky);
        __hip_atomic_store((unsigned*)(BQ + ro), qw, __ATOMIC_RELAXED, __HIP_MEMORY_SCOPE_AGENT);
        __hip_atomic_store((unsigned*)(BK + ro), pg8::cvt_pk_bf16(kx * decx, ky * decy), __ATOMIC_RELAXED, __HIP_MEMORY_SCOPE_AGENT);
    }
    __syncthreads();
    if (w < 3) {
        const int Ia = (w + 1) >> 1, Ja = w >> 1;
        f32x16 a;
#pragma unroll
        for (int r = 0; r < 16; ++r) a[r] = 0.f;
#pragma unroll
        for (int s = 0; s < 8; ++s) {
            const bf16x8 kf = *(const LAS bf16x8*)(lds + G1_KE + (32 * Ja + r32) * G1_QSTR + (16 * s + 8 * hi) * 2);
            const bf16x8 qf = *(const LAS bf16x8*)(lds + G1_QE + (32 * Ia + r32) * G1_QSTR + (16 * s + 8 * hi) * 2);
            a = __builtin_amdgcn_mfma_f32_32x32x16_bf16(kf, qf, a, 0, 0, 0);
        }
        bf16* ap = ATTG + (((long)bh * 32 + n) * 64 + 32 * Ia + r32) * 64 + 32 * Ja + 4 * hi;
#pragma unroll
        for (int g4 = 0; g4 < 4; ++g4) {
            float v[4];
#pragma unroll
            for (int e = 0; e < 4; ++e) { const int jj = 32 * Ja + 8 * g4 + 4 * hi + e, ii = 32 * Ia + r32; v[e] = (jj <= ii) ? a[4 * g4 + e] : 0.f; }
            u32x2 ow; ow.x = pg8::cvt_pk_bf16(v[0], v[1]); ow.y = pg8::cvt_pk_bf16(v[2], v[3]);
            __hip_atomic_store((unsigned long long*)(ap + 8 * g4), ((unsigned long long)ow.y << 32) | ow.x, __ATOMIC_RELAXED, __HIP_MEMORY_SCOPE_AGENT);
        }
    }
    __syncthreads();
}
__device__ __forceinline__ void gla_pre(LAS unsigned char* lds, int bh, int n0, int cnt, bf16* BQ, bf16* BK, const float* LOGA, bf16* ATTG, float* DECG) {
    const int tid = threadIdx.x; const int w = __builtin_amdgcn_readfirstlane(tid >> 6); const int b = bh >> 2, h = bh & 3, c2 = tid & 63;
    PSet A, B;
    pset_load(A, b, h, n0, w, c2, BQ, BK, LOGA);
    for (int j = 0; j < cnt; j += 2) {
        if (j + 1 < cnt) pset_load(B, b, h, n0 + j + 1, w, c2, BQ, BK, LOGA);
        gla_pre_item(A, lds, bh, n0 + j, BQ, BK, ATTG, DECG);
        if (j + 1 < cnt) {
            if (j + 2 < cnt) pset_load(A, b, h, n0 + j + 2, w, c2, BQ, BK, LOGA);
            gla_pre_item(B, lds, bh, n0 + j + 1, BQ, BK, ATTG, DECG);
        }
    }
}
constexpr int G2_TSTR = 144, G2_QSTR = 272;
constexpr int G2_KST = 0, G2_VT = G2_KST + 128 * G2_TSTR, G2_QE = G2_VT + 32 * G2_TSTR, G2_ATT = G2_QE + 64 * G2_QSTR, G2_OP = G2_ATT + 64 * G2_TSTR, G2_SSQ = G2_OP + 32768, G2_END = G2_SSQ + 1024;
static_assert(G2_END <= RING_BYTES && (G2_QE % 16) == 0 && (G2_ATT % 16) == 0 && (G2_OP % 16) == 0 && G1_END <= RING_BYTES, "GLA LDS");
#ifdef PROBE_PHASE
#define GLA_T(k) do { if (blockIdx.x == 0 && c.tid == 0) { const unsigned t_ = (unsigned)__builtin_amdgcn_s_memrealtime(); volatile LAS unsigned* M_ = (volatile LAS unsigned*)(lds + MISC_OFF); \
        if ((k) > 0) M_[26 + (k)] += t_ - M_[26]; M_[26] = t_; } } while (0)
#else
#define GLA_T(k) do {} while (0)
#endif
struct GSet { unsigned ks2[8]; u32x2 vq; u32x4 qe[2]; u32x4 att; f32x4 dec[4]; };
struct GCtx { const bf16* QE; const bf16* KS; const bf16* BV; const bf16* ATTG; const float* DECG; bf16* OBU; float* SSB; int bh, sl, b, h, kb, I, c2, vtok, vd4, w, lane, r32, hi, tid; bool has_intra; };
__device__ __forceinline__ void gset_load(GSet& s, const GCtx& c, int n) {
    const long tk = (long)c.b * T + n * 64; const long it = (long)c.bh * 32 + n;
    s.vq = *(const GAS u32x2*)(c.BV + (tk + c.vtok) * 1024 + c.h * 256 + 32 * c.sl + c.vd4);
#pragma unroll
    for (int i = 0; i < 8; ++i) s.ks2[i] = *(const GAS unsigned*)(c.KS + (tk + 8 * c.w + i) * 512 + c.h * 128 + 2 * c.c2);
#pragma unroll
    for (int j = 0; j < 2; ++j) { const int p = c.tid + 512 * j; s.qe[j] = *(const GAS u32x4*)(c.QE + (tk + (p >> 4)) * 512 + c.h * 128 + (p & 15) * 8); }
    s.att = *(const GAS u32x4*)(c.ATTG + (it * 64 + (c.tid >> 3)) * 64 + (c.tid & 7) * 8);
#pragma unroll
    for (int g = 0; g < 4; ++g) s.dec[g] = *(const GAS f32x4*)(c.DECG + it * 128 + 32 * c.kb + 8 * g + 4 * c.hi);
}
__device__ __forceinline__ void gla_chunk(GSet& s, const GCtx& c, int n, f32x16& S, LAS unsigned char* lds) {
    const long tokc = (long)c.b * T + n * 64;
    LAS unsigned char* buf = lds;
    LAS float* SSQ = (LAS float*)(lds + G2_SSQ);
    const int kb = c.kb, I = c.I, r32 = c.r32, hi = c.hi, lane = c.lane;
    u32x4 sw[2];
#pragma unroll
    for (int s2 = 0; s2 < 2; ++s2) { sw[s2].x = pg8::cvt_pk_bf16(S[8 * s2 + 0], S[8 * s2 + 1]); sw[s2].y = pg8::cvt_pk_bf16(S[8 * s2 + 2], S[8 * s2 + 3]);
        sw[s2].z = pg8::cvt_pk_bf16(S[8 * s2 + 4], S[8 * s2 + 5]); sw[s2].w = pg8::cvt_pk_bf16(S[8 * s2 + 6], S[8 * s2 + 7]); }
#pragma unroll
    for (int r = 0; r < 16; ++r) S[r] *= s.dec[r >> 2][r & 3];
    asm volatile("" : "+v"(S));
    GLA_T(0);
    {
        v4u kx, ky;
        kx.x = (s.ks2[0] & 0xffffu) | (s.ks2[1] << 16); kx.y = (s.ks2[2] & 0xffffu) | (s.ks2[3] << 16); kx.z = (s.ks2[4] & 0xffffu) | (s.ks2[5] << 16); kx.w = (s.ks2[6] & 0xffffu) | (s.ks2[7] << 16);
        ky.x = (s.ks2[0] >> 16) | (s.ks2[1] & 0xffff0000u); ky.y = (s.ks2[2] >> 16) | (s.ks2[3] & 0xffff0000u); ky.z = (s.ks2[4] >> 16) | (s.ks2[5] & 0xffff0000u); ky.w = (s.ks2[6] >> 16) | (s.ks2[7] & 0xffff0000u);
        *(LAS v4u*)(buf + G2_KST + (2 * c.c2) * G2_TSTR + 16 * c.w) = kx;
        *(LAS v4u*)(buf + G2_KST + (2 * c.c2 + 1) * G2_TSTR + 16 * c.w) = ky;
        LAS unsigned short* vt = (LAS unsigned short*)(buf + G2_VT + c.vd4 * G2_TSTR + c.vtok * 2);
        vt[0] = (unsigned short)(s.vq.x & 0xffff); vt[G2_TSTR / 2] = (unsigned short)(s.vq.x >> 16);
        vt[2 * (G2_TSTR / 2)] = (unsigned short)(s.vq.y & 0xffff); vt[3 * (G2_TSTR / 2)] = (unsigned short)(s.vq.y >> 16);
#pragma unroll
        for (int j = 0; j < 2; ++j) { const int p = c.tid + 512 * j; *(LAS u32x4*)(buf + G2_QE + (p >> 4) * G2_QSTR + (p & 15) * 16) = s.qe[j]; }
        *(LAS u32x4*)(buf + G2_ATT + (c.tid >> 3) * G2_TSTR + (c.tid & 7) * 16) = s.att;
    }
    __syncthreads();
    GLA_T(1);
    if (n > 0 && c.tid < 64) { const float q = (SSQ[c.tid] + SSQ[64 + c.tid]) + (SSQ[128 + c.tid] + SSQ[192 + c.tid]);
        __hip_atomic_fetch_add(c.SSB + (tokc - 64 + c.tid) * 4 + c.h, q, __ATOMIC_RELAXED, __HIP_MEMORY_SCOPE_AGENT); }
    f32x16 oT;
#pragma unroll
    for (int r = 0; r < 16; ++r) oT[r] = 0.f;
#pragma unroll
    for (int s2 = 0; s2 < 2; ++s2) {
        const LAS unsigned char* qp = buf + G2_QE + (32 * I + r32) * G2_QSTR + (32 * kb + 16 * s2 + 4 * hi) * 2;
        const u32x2 a0 = *(const LAS u32x2*)qp, a1 = *(const LAS u32x2*)(qp + 16);
        const u32x4 qw = (u32x4){a0.x, a0.y, a1.x, a1.y};
        oT = __builtin_amdgcn_mfma_f32_32x32x16_bf16(__builtin_bit_cast(bf16x8, sw[s2]), __builtin_bit_cast(bf16x8, qw), oT, 0, 0, 0);
    }
    bf16x8 vf[4];
#pragma unroll
    for (int k = 0; k < 4; ++k) vf[k] = *(const LAS bf16x8*)(buf + G2_VT + r32 * G2_TSTR + (16 * k + 8 * hi) * 2);
#pragma unroll
    for (int k = 0; k < 4; ++k) {
        const bf16x8 kf = *(const LAS bf16x8*)(buf + G2_KST + (32 * kb + r32) * G2_TSTR + (16 * k + 8 * hi) * 2);
        S = __builtin_amdgcn_mfma_f32_32x32x16_bf16(kf, vf[k], S, 0, 0, 0);
    }
    if (c.has_intra) {
        const bf16x8 vk = *(const LAS bf16x8*)(buf + G2_VT + r32 * G2_TSTR + (16 * kb + 8 * hi) * 2);
        const bf16x8 af = *(const LAS bf16x8*)(buf + G2_ATT + (32 * I + r32) * G2_TSTR + (16 * kb + 8 * hi) * 2);
        oT = __builtin_amdgcn_mfma_f32_32x32x16_bf16(vk, af, oT, 0, 0, 0);
    }
    if (n + 2 < 32) gset_load(s, c, n + 2);
#pragma unroll
    for (int g4 = 0; g4 < 4; ++g4) *(LAS f32x4*)(lds + G2_OP + (((kb * 2 + I) * 4 + g4) * 64 + lane) * 16) = (f32x4){oT[4 * g4], oT[4 * g4 + 1], oT[4 * g4 + 2], oT[4 * g4 + 3]};
    __syncthreads();
    GLA_T(2);
    f32x4 v = *(const LAS f32x4*)(lds + G2_OP + (((0 * 2 + I) * 4 + kb) * 64 + lane) * 16);
#pragma unroll
    for (int kw = 1; kw < 4; ++kw) v += *(const LAS f32x4*)(lds + G2_OP + (((kw * 2 + I) * 4 + kb) * 64 + lane) * 16);
    { u32x2 ow; ow.x = pg8::cvt_pk_bf16(v[0], v[1]); ow.y = pg8::cvt_pk_bf16(v[2], v[3]);
      __hip_atomic_store((unsigned long long*)(c.OBU + (tokc + 32 * I + r32) * 1024 + c.h * 256 + 32 * c.sl + 8 * kb + 4 * hi), ((unsigned long long)ow.y << 32) | ow.x, __ATOMIC_RELAXED, __HIP_MEMORY_SCOPE_AGENT); }
    float ss = (v[0] * v[0] + v[1] * v[1]) + (v[2] * v[2] + v[3] * v[3]);
    ss += __shfl_xor(ss, 32);
    if (hi == 0) SSQ[kb * 64 + 32 * I + r32] = ss;
    GLA_T(3);
}
__device__ __forceinline__ void gla_serial(LAS unsigned char* lds, int bh, int sl, const bf16* QE, const bf16* KS, const bf16* BV, const bf16* ATTG, const float* DECG, bf16* OBU, float* SSB) {
    GCtx c; c.QE = QE; c.KS = KS; c.BV = BV; c.ATTG = ATTG; c.DECG = DECG; c.OBU = OBU; c.SSB = SSB; c.bh = bh; c.sl = sl; c.b = bh >> 2; c.h = bh & 3;
    c.tid = threadIdx.x; c.lane = c.tid & 63; c.r32 = c.lane & 31; c.hi = c.lane >> 5; c.w = __builtin_amdgcn_readfirstlane(c.tid >> 6);
    c.kb = c.w & 3; c.I = c.w >> 2; c.c2 = c.tid & 63; c.vtok = c.tid >> 3; c.vd4 = (c.tid & 7) * 4; c.has_intra = (c.I == 1) || (c.kb < 2);
    f32x16 S;
#pragma unroll
    for (int r = 0; r < 16; ++r) S[r] = 0.f;
    GSet A, B;
    gset_load(A, c, 0); gset_load(B, c, 1);
    for (int n = 0; n < 32; n += 2) { gla_chunk(A, c, n, S, lds); gla_chunk(B, c, n + 1, S, lds); }
    __syncthreads();
    LAS float* SSQ = (LAS float*)(lds + G2_SSQ);
    if (c.tid < 64) { const float q = (SSQ[c.tid] + SSQ[64 + c.tid]) + (SSQ[128 + c.tid] + SSQ[192 + c.tid]);
        __hip_atomic_fetch_add(SSB + ((long)c.b * T + 31 * 64 + c.tid) * 4 + c.h, q, __ATOMIC_RELAXED, __HIP_MEMORY_SCOPE_AGENT); }
    __syncthreads();
}

__device__ __forceinline__ void gla_norm_rows(int bh, int t0, int cnt, int wave, int nwaves, int lane, const bf16* OBU, bf16* BG, const float* SSB, const float* nw) {
    const int b = bh >> 2, h = bh & 3;
    const f32x4 w4 = *(const GAS f32x4*)(nw + 4 * lane);
    constexpr int NB = 16;
    for (int tb = t0 + wave; tb < t0 + cnt; tb += nwaves * NB) {
        float ssv[NB]; u32x2 ov[NB], gv[NB];
#pragma unroll
        for (int j = 0; j < NB; ++j) { const int t = tb + j * nwaves; const long tok = (long)b * T + (t < t0 + cnt ? t : t0);
            ssv[j] = __hip_atomic_load(SSB + tok * 4 + h, __ATOMIC_RELAXED, __HIP_MEMORY_SCOPE_AGENT);
            ov[j] = *(const GAS u32x2*)(OBU + tok * 1024 + h * 256 + 4 * lane); gv[j] = *(const GAS u32x2*)(BG + tok * 2048 + h * 256 + 4 * lane); }
#pragma unroll
        for (int j = 0; j < NB; ++j) { const int t = tb + j * nwaves;
            if (t < t0 + cnt) { const long tok = (long)b * T + t;
                const float rstd = 1.0f / sqrtf(ssv[j] * (1.0f / 256.0f) + EPS);
                u32x2 r; r.x = pg8::cvt_pk_bf16(pg8::bf_lo(ov[j].x) * rstd * w4[0] * pg8::bf_lo(gv[j].x), pg8::bf_hi(ov[j].x) * rstd * w4[1] * pg8::bf_hi(gv[j].x));
                r.y = pg8::cvt_pk_bf16(pg8::bf_lo(ov[j].y) * rstd * w4[2] * pg8::bf_lo(gv[j].y), pg8::bf_hi(ov[j].y) * rstd * w4[3] * pg8::bf_hi(gv[j].y));
                *(GAS u32x2*)(BG + tok * 2048 + h * 256 + 4 * lane) = r; } }
    }
}
struct Args { const float* in[12]; float* out; unsigned char* ws; int ph_lo, ph_hi, use_cg, dummy; };
constexpr int N_PHASES = 7;
__global__ void __launch_bounds__(NWAVES * 64, 2) hybrid_fwd(Args args) {
    extern __shared__ __attribute__((aligned(16))) unsigned char lds[];
    Frame F;
    F.lds = (LAS unsigned char*)lds;
    F.MISC = (volatile LAS unsigned*)(F.lds + MISC_OFF);
    F.tid = threadIdx.x; F.lane = F.tid & 63; F.wave = __builtin_amdgcn_readfirstlane(F.tid >> 6);
    F.G = gridDim.x; { const int bx = blockIdx.x; F.vcu = (F.G % 8 == 0) ? (bx % 8) * (F.G / 8) + bx / 8 : bx; }
    unsigned char* ws = args.ws;
    gu32* ctl = (gu32*)(ws + WS_CTL);
    const float* x = args.in[0]; const int* positions = (const int*)args.in[1]; const float* norm_w = args.in[2]; const float* w_in = args.in[3];
    const float* a_sinks = args.in[4]; const float* b_gate_up = args.in[5]; const float* b_gate_bias = args.in[6]; const float* b_out_norm_w = args.in[7];
    const float* w_a_proj = args.in[8]; const float* w_b_proj = args.in[9]; const float* w_out = args.in[10]; const float* final_norm_w = args.in[11];
    bf16* W1t = (bf16*)(ws + WS_W1); bf16* Wabt = (bf16*)(ws + WS_WA);     bf16* Wot = (bf16*)(ws + WS_WO);
    bf16* XN = (bf16*)(ws + WS_XN); bf16* Qb = (bf16*)(ws + WS_Q); bf16* KVb = (bf16*)(ws + WS_KV); bf16* BQb = (bf16*)(ws + WS_BQ); bf16* BKb = (bf16*)(ws + WS_BK);
    bf16* BVb = (bf16*)(ws + WS_BV); bf16* AGb = (bf16*)(ws + WS_AG); bf16* BGb = AGb + 1024;     float* LOGA = (float*)(ws + WS_LOGA);
    float* YA = (float*)(ws + WS_YA); bf16* MERGED = XN; bf16* OBU = XN; float* SS2 = (float*)(ws + WS_SS2); float* SSB = (float*)(ws + WS_SSB);
    bf16* MAb = (bf16*)args.out; bf16* MBb = MAb + (size_t)M * 1024;
    for (int u = F.tid; u < (LDS_BYTES - LDSCTL_OFF) / 4; u += NWAVES * 64) ((LAS unsigned*)(F.lds + LDSCTL_OFF))[u] = 0u;
    __syncthreads();
    XcdBarrier bar = xcd_barrier_post((unsigned*)(ctl + CW_BAR), F.MISC + 8);
    const int lo = args.ph_lo, hi = args.ph_hi;
#define IN(k) (lo <= (k) && (k) < hi)
#define BOTH(k) (IN(k) && IN((k) + 1))
#define GRID_BAR() do { if (args.use_cg) cg::this_grid().sync(); else xcd_barrier(bar); } while (0)
#ifdef PROBE_PHASE
#define STAMP(k) do { if (blockIdx.x == 0 && F.tid == 0) F.MISC[16 + (k)] = (unsigned)__builtin_amdgcn_s_memrealtime(); } while (0)
    STAMP(0);
#else
#define STAMP(k) do {} while (0)
#endif

    if (IN(0)) {
        LAS float* scr = (LAS float*)(F.lds + RING_OFF + F.wave * 16384);
        const int gw = F.vcu * NWAVES + F.wave, NGW = F.G * NWAVES;
        constexpr int I_1 = 16 * (7424 / 32), I_F = 16 * (512 / 32), I_S = 16 * 32;
        constexpr int NITEMS = I_1 + I_F;
        for (int it = gw; it < NITEMS; it += NGW) {
            int r = it;
            if (r < I_1) { const int kb = r / 232, nb = r % 232; p0_transpose_item(w_in, INW, 1024, W1t, 32 * nb, 64 * kb, src_col_w1(32 * nb + (F.lane & 31)), scr, F.lane); continue; } r -= I_1;
            { const int kb = r / 16, eb = r % 16; p0_fold_item(w_in, b_gate_up, W1t, 32 * eb, 64 * kb, scr, F.lane); }
        }
        for (int m = gw; m < M; m += 4 * NGW) rms_rows4_to_bf16(F.lane, x, norm_w, XN, m, NGW);
        for (int i = blockIdx.x * 512 + F.tid; i < M; i += F.G * 512) SS2[i] = 0.f;
        for (int i = blockIdx.x * 512 + F.tid; i < M * 4; i += F.G * 512) SSB[i] = 0.f;
        if (BOTH(0)) GRID_BAR();
        STAMP(1);
    }
    if (IN(1)) {
        const int n_full = (F.G == 256) ? 192 : 0;
        if ((int)blockIdx.x >= n_full) {
            LAS float* scr = (LAS float*)(F.lds + RING_OFF + F.wave * 16384);
            const int nb2 = F.G - n_full; const int gw2 = ((int)blockIdx.x - n_full) * NWAVES + F.wave, NGW2 = nb2 * NWAVES;
            constexpr int I_S = 16 * 32;
            for (int it = gw2; it < 3 * I_S; it += NGW2) {
                int r = it; const int mat = r / I_S; r -= mat * I_S; const int kb = r / 32, nb = r % 32;
                const float* Wsrc = mat == 0 ? w_a_proj : (mat == 1 ? w_b_proj : w_out); bf16* Wdst = mat == 0 ? Wabt : (mat == 1 ? Wabt + 1024 : Wot);
                p0_transpose_item(Wsrc, 1024, mat == 2 ? 1024 : 2048, Wdst, 32 * nb, 64 * kb, 32 * nb + (F.lane & 31), scr, F.lane);
            }
            asm volatile("s_waitcnt vmcnt(0) lgkmcnt(0)" ::: "memory");
#ifdef STAGGER_TICKS
            { const unsigned long long t0 = __builtin_amdgcn_s_memrealtime(); while (__builtin_amdgcn_s_memrealtime() - t0 < STAGGER_TICKS) __builtin_amdgcn_s_sleep(8); }
#endif
            __syncthreads();
        }
        pg8::Gemm g{XN, W1t, M, N1, D, D}; pg8::StaticOrder S; S.init(M, N1, F.G, (int)blockIdx.x);
        pg8::EpiP1 E{ws, (unsigned char*)args.out, positions, b_gate_bias};
        pg8::gemm_phase<pg8::EpiP1, pg8::StaticOrder, true, true>(F.lds + RING_OFF, g, S, E);
        if (BOTH(1)) GRID_BAR();
        STAMP(2);
    }
    if (IN(2)) {
        bf16* ATTG = (bf16*)(ws + WS_W1); float* DECG = (float*)(ws + WS_W1 + 8 * MiB);
        if (F.G == 256) {
            const int bh = F.vcu >> 3, sl = F.vcu & 7;
            unsigned* gc = (unsigned*)(ctl + CW_GLA + 64 * bh);
            const int au = F.vcu;
            const bool serial_first = (bh & 1) != 0;
            if (!serial_first && (F.vcu & 1)) attn_unit(F.lds + RING_OFF, au >> 5, (au >> 1) & 15, au & 1, Qb, KVb, AGb, a_sinks);
            gla_pre(F.lds + RING_OFF, bh, 4 * sl, 4, BQb, BKb, LOGA, ATTG, DECG);
            asm volatile("s_waitcnt vmcnt(0)" ::: "memory");
            __syncthreads();
            if (F.tid == 0) { __hip_atomic_fetch_add(gc, 1u, __ATOMIC_RELAXED, __HIP_MEMORY_SCOPE_AGENT); }
            STAMP(8);
            if (!serial_first && !(F.vcu & 1)) attn_unit(F.lds + RING_OFF, au >> 5, (au >> 1) & 15, au & 1, Qb, KVb, AGb, a_sinks);
            STAMP(9);
            if (F.tid == 0) { unsigned sp = 0; while (__hip_atomic_load(gc, __ATOMIC_RELAXED, __HIP_MEMORY_SCOPE_AGENT) < 8u) { __builtin_amdgcn_s_sleep(2); if (++sp > (1u << 22)) break; }
                __builtin_amdgcn_fence(__ATOMIC_ACQUIRE, "agent"); asm volatile("s_waitcnt vmcnt(0)" ::: "memory"); }
            __syncthreads();
            gla_serial(F.lds + RING_OFF, bh, sl, BQb, BKb, BVb, ATTG, DECG, OBU, SSB);
            STAMP(10);
            unsigned* gc2 = gc + 32;
            asm volatile("s_waitcnt vmcnt(0)" ::: "memory");
            __syncthreads();
            if (F.tid == 0) __hip_atomic_fetch_add(gc2, 1u, __ATOMIC_RELAXED, __HIP_MEMORY_SCOPE_AGENT);
            if (serial_first) attn_unit(F.lds + RING_OFF, au >> 5, (au >> 1) & 15, au & 1, Qb, KVb, AGb, a_sinks);
            if (F.tid == 0) { unsigned sp = 0; while (__hip_atomic_load(gc2, __ATOMIC_RELAXED, __HIP_MEMORY_SCOPE_AGENT) < 8u) { __builtin_amdgcn_s_sleep(2); if (++sp > (1u << 22)) break; }
                __builtin_amdgcn_fence(__ATOMIC_ACQUIRE, "agent"); asm volatile("s_waitcnt vmcnt(0)" ::: "memory"); }
            __syncthreads();
            gla_norm_rows(bh, 256 * sl, 256, F.wave, NWAVES, F.lane, OBU, BGb, SSB, b_out_norm_w);
            STAMP(11);
        } else {
            for (int it = F.vcu; it < 1024; it += F.G) gla_pre(F.lds + RING_OFF, it >> 5, it & 31, 1, BQb, BKb, LOGA, ATTG, DECG);
            GRID_BAR();
            for (int it = F.vcu; it < 256; it += F.G) gla_serial(F.lds + RING_OFF, it >> 3, it & 7, BQb, BKb, BVb, ATTG, DECG, OBU, SSB);
            for (int u = blockIdx.x; u < 256; u += F.G) attn_unit(F.lds + RING_OFF, u >> 5, (u >> 1) & 15, u & 1, Qb, KVb, AGb, a_sinks);
            GRID_BAR();
            for (int it = F.vcu; it < 256; it += F.G) gla_norm_rows(it >> 3, 256 * (it & 7), 256, F.wave, NWAVES, F.lane, OBU, BGb, SSB, b_out_norm_w);
        }
        if (BOTH(2)) GRID_BAR();
        STAMP(3);
    }
    STAMP(4);
    if (IN(4)) {
        pg8::Gemm g{AGb, Wabt, M, D, D, 2 * D}; pg8::StaticOrder2 S; S.init(M, D, F.G, (int)blockIdx.x);
        pg8::EpiMerge2 E{MAb, MBb, MERGED};
        pg8::gemm_phase<pg8::EpiMerge2, pg8::StaticOrder2, false, true, true>(F.lds + RING_OFF, g, S, E);
        if (BOTH(4)) GRID_BAR();
        STAMP(5);
    }
    const bool fuse_out = (F.G == 256);
    if (IN(5)) {
        pg8::Gemm g{MERGED, Wot, M, D, D, D}; pg8::StaticOrder S; S.init(M, D, F.G, (int)blockIdx.x);
        if (fuse_out) {
            pg8::EpiOutNorm E{x, args.out, SS2, (unsigned*)(ctl + CW_PANEL), final_norm_w};
            pg8::gemm_phase<pg8::EpiOutNorm, pg8::StaticOrder, false, true>(F.lds + RING_OFF, g, S, E);
        } else {
            pg8::EpiOut E{x, args.out, SS2};
            pg8::gemm_phase<pg8::EpiOut, pg8::StaticOrder, true, true>(F.lds + RING_OFF, g, S, E);
        }
        if (BOTH(5) && !fuse_out) GRID_BAR();
        STAMP(6);
    }
    if (IN(6) && !fuse_out) {
        const int gw = blockIdx.x * NWAVES + F.wave, NGW = F.G * NWAVES;
        for (int m = gw; m < M; m += NGW) {
            const float rstd = 1.0f / sqrtf(SS2[m] * (1.0f / D) + EPS);
            GAS f32x4* o = (GAS f32x4*)(args.out + (size_t)m * D) + F.lane; const GAS f32x4* fw = (const GAS f32x4*)final_norm_w + F.lane;
#pragma unroll
            for (int j = 0; j < 4; ++j) o[64 * j] = o[64 * j] * rstd * fw[64 * j];
        }
    }
#ifdef PROBE_PHASE
    STAMP(7);
    if (blockIdx.x == 0 && F.tid == 0) {
        const unsigned d = (PROBE_PHASE == 20 ? (F.MISC[16 + 8] - F.MISC[16 + 2]) : PROBE_PHASE == 21 ? (F.MISC[16 + 9] - F.MISC[16 + 8]) : PROBE_PHASE == 22 ? (F.MISC[16 + 3] - F.MISC[16 + 9]) : PROBE_PHASE == 23 ? (F.MISC[16 + 10] - F.MISC[16 + 9]) : PROBE_PHASE == 24 ? (F.MISC[16 + 11] - F.MISC[16 + 10]) : PROBE_PHASE == 25 ? (F.MISC[16 + 3] - F.MISC[16 + 11]) : PROBE_PHASE >= 30 ? F.MISC[26 + PROBE_PHASE - 29] : (F.MISC[16 + PROBE_PHASE + 1] - F.MISC[16 + PROBE_PHASE])) * 4u; const unsigned t0 = (unsigned)__builtin_amdgcn_s_memrealtime();
        while ((unsigned)__builtin_amdgcn_s_memrealtime() - t0 < d) __builtin_amdgcn_s_sleep(8);
    }
#endif
#undef IN
#undef BOTH
}

#ifndef MK_N_LAUNCHES
#define MK_N_LAUNCHES 1
#endif
#ifndef MK_USE_CG
#define MK_USE_CG 0
#endif
extern "C" void kernel_launch(void* const* d_in, const int* in_sizes, int n_in, void* d_out, int out_size, void* d_ws, size_t ws_size, hipStream_t stream) {
    static int grid = 0;
    if (grid == 0) {
        if (n_in != 12 || in_sizes[0] != M * D || out_size != M * D || ws_size < WS_END) { fprintf(stderr, "kernel_launch: unexpected shapes (n_in %d, in0 %d, out %d, ws %zu)\n", n_in, n_in > 0 ? in_sizes[0] : -1, out_size, ws_size); grid = -1; return; }
        int dev = 0, cus = 0, per_cu = 0;
        if (hipGetDevice(&dev) != hipSuccess || hipDeviceGetAttribute(&cus, hipDeviceAttributeMultiprocessorCount, dev) != hipSuccess) { grid = -1; return; }
        if (hipFuncSetAttribute((const void*)hybrid_fwd, hipFuncAttributeMaxDynamicSharedMemorySize, LDS_BYTES) != hipSuccess) { fprintf(stderr, "kernel_launch: hipFuncSetAttribute failed\n"); grid = -1; return; }
        if (hipOccupancyMaxActiveBlocksPerMultiprocessor(&per_cu, (const void*)hybrid_fwd, NWAVES * 64, LDS_BYTES) != hipSuccess || per_cu < 1) { fprintf(stderr, "kernel_launch: occupancy query says %d\n", per_cu); per_cu = 1; }
        (void)hipGetLastError();
        grid = cus;
    }
    if (grid < 0) return;
    if (hipMemsetAsync((char*)d_ws + WS_CTL, 0, CTL_ZERO_BYTES, stream) != hipSuccess) { fprintf(stderr, "kernel_launch: memset failed\n"); return; }
    Args a{};
    for (int i = 0; i < 12; ++i) a.in[i] = (const float*)d_in[i];
    a.out = (float*)d_out; a.ws = (unsigned char*)d_ws; a.use_cg = MK_USE_CG; a.dummy = 0;
    if (MK_N_LAUNCHES == 1) {
        a.ph_lo = 0; a.ph_hi = N_PHASES;
        void* kargs[] = {&a};
        hipError_t e = hipLaunchCooperativeKernel((const void*)hybrid_fwd, dim3(grid), dim3(NWAVES * 64), kargs, LDS_BYTES, stream);
        if (e != hipSuccess) fprintf(stderr, "kernel_launch: cooperative launch failed: %s (grid %d)\n", hipGetErrorString(e), grid);
    } else {
        for (int li = 0; li < N_PHASES; ++li) {
            a.ph_lo = li; a.ph_hi = li + 1;
#ifdef PROBE_DUP
            if (li == PROBE_DUP) { a.dummy = (li == 2); hipLaunchKernelGGL(hybrid_fwd, dim3(grid), dim3(NWAVES * 64), LDS_BYTES, stream, a); a.dummy = 0; }
#endif
            hipLaunchKernelGGL(hybrid_fwd, dim3(grid), dim3(NWAVES * 64), LDS_BYTES, stream, a);
        }
    }
}
```

```cpp
#include <hip/hip_runtime.h>
#include <hip/hip_cooperative_groups.h>
#include <cstdio>
#include <cstdint>
#include <cmath>
namespace cg = cooperative_groups;
constexpr int NWAVES = 8;
constexpr int BATCH = 8, T = 2048, D = 1024, M = BATCH * T;
constexpr int N1 = 7936;
constexpr int INW = 7440;
constexpr float EPS = 1e-5f;
constexpr size_t MiB = 1u << 20;
constexpr size_t WS_CTL = 0, CTL_ZERO_BYTES = 128 * 1024;
constexpr size_t WS_SS2 = 256 * 1024;
constexpr size_t WS_SSB = 512 * 1024;
constexpr size_t WS_W1 = 1 * MiB;
constexpr size_t WS_WA = WS_W1 + (size_t)N1 * 1024 * 2, WS_WB = WS_WA + 2 * MiB, WS_WO = WS_WB + 2 * MiB;
constexpr size_t WS_XN = 23 * MiB;
constexpr size_t WS_Q = 55 * MiB;
constexpr size_t WS_KV = 87 * MiB;
constexpr size_t WS_BQ = 95 * MiB, WS_BK = 111 * MiB;
constexpr size_t WS_BV = 127 * MiB;
constexpr size_t WS_AG = 159 * MiB;
constexpr size_t WS_BG = 191 * MiB;
constexpr size_t WS_LOGA = 223 * MiB;
constexpr size_t WS_END = 255 * MiB;
constexpr size_t WS_YA = WS_Q;
static_assert(WS_WO + 2 * MiB <= WS_XN && WS_YA + 64 * MiB <= WS_BV, "ws map");
constexpr int CW_BAR = 4096, CW_PANEL = 8192, CW_GLA = 12288;
namespace pg8 {
#define PG8_LAS __attribute__((address_space(3)))
typedef unsigned short bf16_t;
typedef short bf16x8 __attribute__((ext_vector_type(8)));
typedef float f32x4 __attribute__((ext_vector_type(4)));
typedef unsigned u32x4 __attribute__((ext_vector_type(4)));
constexpr int BM = 256, BK = 64, HALF = 128, HTB = HALF * BK * 2  , STAGE_BYTES = 8 * HTB, NXCD = 8, WGM = 4;

__host__ __device__ __forceinline__ int lds_byte(int r, int c) { const int st = (r >> 4) * 2 + (c >> 5), rr = r & 15, cc = c & 31, ob = rr * 64 + cc * 2; return st * 1024 + (ob ^ (((ob >> 9) & 1) << 5)); }
__host__ __device__ __forceinline__ void stage_rc(int b, int& R, int& C) { const int st = b / 1024, sb = b % 1024, swz = sb ^ (((sb >> 9) & 1) << 5); R = (st >> 1) * 16 + swz / 64; C = (st & 1) * 32 + (swz % 64) / 2; }
__host__ __device__ __forceinline__ int perm32(int rho) { const int n = rho >> 4, i = rho & 15; return 8 * (i >> 2) + 4 * n + (i & 3); }

struct Unit { int pm, pn, seg; };
struct Gemm { const bf16_t* A; const bf16_t* Bt; int M, N, K, ld; };

struct StaticOrder {
    int nM, nN, nwg, G, c;
    __host__ __device__ void init(int M, int N, int G_, int c_) { nM = M / BM; nN = N / BM; nwg = nM * nN; G = G_; c = c_; }
    __host__ __device__ bool next(int i, Unit& u) const {
        const long L = (long)i * G + c; if (L >= nwg) return false;
        int wgid = (int)L; { const int q = nwg / NXCD, r = nwg % NXCD, xcd = wgid % NXCD, off = wgid / NXCD; wgid = (xcd < r ? xcd * (q + 1) : r * (q + 1) + (xcd - r) * q) + off; }
        const int nig = WGM * nN, gid = wgid / nig, fm = gid * WGM, gsz = (nM - fm) < WGM ? (nM - fm) : WGM;
        u.pm = fm + ((wgid % nig) % gsz); u.pn = (wgid % nig) / gsz; u.seg = 0; return true;
    }
    __device__ __forceinline__ void a_ready(const Unit&) const {}
    __device__ __forceinline__ void done(const Unit&) const {}
};


struct StaticOrder2 {
    StaticOrder in;
    __host__ __device__ void init(int M, int N, int G_, int c_) { in.init(M, N, G_, c_); }
    __host__ __device__ bool next(int i, Unit& u) const { if (!in.next(i >> 1, u)) return false; u.seg = i & 1; return true; }
    __device__ __forceinline__ void a_ready(const Unit&) const {}
    __device__ __forceinline__ void done(const Unit&) const {}
};

__device__ __forceinline__ unsigned cvt_pk_bf16(float lo, float hi) { unsigned r; asm volatile("v_cvt_pk_bf16_f32 %0, %1, %2" : "=v"(r) : "v"(lo), "v"(hi)); return r; }
__device__ __forceinline__ float bf_lo(unsigned w) { return __uint_as_float(w << 16); }
__device__ __forceinline__ float bf_hi(unsigned w) { return __uint_as_float(w & 0xffff0000u); }
__device__ __forceinline__ void store8bf(bf16_t* p, const f32x4& v0, const f32x4& v1) {
    u32x4 w; w.x = cvt_pk_bf16(v0[0], v0[1]); w.y = cvt_pk_bf16(v0[2], v0[3]); w.z = cvt_pk_bf16(v1[0], v1[1]); w.w = cvt_pk_bf16(v1[2], v1[3]); *(u32x4*)p = w;
}
__device__ __forceinline__ void load8bf(const bf16_t* p, f32x4& v0, f32x4& v1) {
    const u32x4 w = *(const u32x4*)p;
    v0 = (f32x4){bf_lo(w.x), bf_hi(w.x), bf_lo(w.y), bf_hi(w.y)}; v1 = (f32x4){bf_lo(w.z), bf_hi(w.z), bf_lo(w.w), bf_hi(w.w)};
}
__device__ __forceinline__ void sincos_cw(float a, float& s, float& c) {
    const float kf = rintf(a * 0.63661977236758134f);
    float r = fmaf(-kf, 1.5703125f, a); r = fmaf(-kf, 4.837512969970703125e-4f, r); r = fmaf(-kf, 7.54978995489188216e-8f, r);
    const float r2 = r * r;
    float sp = fmaf(r2, 2.7557319e-6f, -1.9841270e-4f); sp = fmaf(sp, r2, 8.3333333e-3f); sp = fmaf(sp, r2, -1.6666667e-1f); sp = fmaf(sp * r2, r, r);
    float cp = fmaf(r2, -2.7557319e-7f, 2.4801587e-5f); cp = fmaf(cp, r2, -1.3888889e-3f); cp = fmaf(cp, r2, 4.1666667e-2f); cp = fmaf(cp, r2, -0.5f); cp = fmaf(cp, r2, 1.0f);
    const int q = ((int)kf) & 3;
    const float s1 = (q & 1) ? cp : sp, c1 = (q & 1) ? sp : cp;
    s = (q & 2) ? -s1 : s1; c = ((q + 1) & 2) ? -c1 : c1;
}
constexpr float QSCALE = 0.125f * 1.4426950408889634f;
struct EpiP1 {
    static constexpr bool PERM = true, AFTER_DRAIN = false;
    unsigned char* ws; unsigned char* outb; const int* pos; const float* gbias;
    __device__ __forceinline__ void operator()(const f32x4 (&acc)[2][2][4][2], const Unit& u, int wr, int wc, int fr, int fq) const {
        const int pn = u.pn; const int row0 = u.pm * BM + wr * 64 + fr; const int cl = wc * 32 + 8 * fq;
        if (pn <= 4) {
            bf16_t* base = (bf16_t*)(ws + (pn < 4 ? WS_Q + (size_t)pn * 512 : WS_KV)); const int ld = pn < 4 ? 1024 : 256; const float sc = pn < 4 ? QSCALE : 1.0f;
            float invf[4];
#pragma unroll
            for (int i = 0; i < 4; ++i) invf[i] = exp2f(-(float)(16 * (wc & 1) + 4 * fq + i) * (13.287712379549449f / 32.0f));
#pragma unroll
            for (int ai = 0; ai < 2; ++ai)
#pragma unroll
                for (int m = 0; m < 4; ++m) {
                    const int row = row0 + ai * HALF + m * 16; const float pf = (float)pos[row];
                    f32x4 cs, sn;
#pragma unroll
                    for (int i = 0; i < 4; ++i) { float s_, c_; sincos_cw(pf * invf[i], s_, c_); cs[i] = c_ * sc; sn[i] = s_ * sc; }
#pragma unroll
                    for (int bj = 0; bj < 2; ++bj) {
                        const f32x4 x1 = acc[ai][bj][m][0], x2 = acc[ai][bj][m][1];
                        f32x4 o1, o2;
                        if (pn == 4 && bj == 1) { o1 = x1; o2 = x2; }
                        else { o1 = x1 * cs - x2 * sn; o2 = x2 * cs + x1 * sn; }
                        store8bf(base + (size_t)row * ld + bj * HALF + cl, o1, o2);
                    }
                }
        } else if (pn >= 29) {
            const int cgk = (pn - 29) * 256 + cl;
#pragma unroll
            for (int bj = 0; bj < 2; ++bj) {
                const f32x4 b0 = *(const f32x4*)(gbias + cgk + bj * HALF), b1 = *(const f32x4*)(gbias + cgk + bj * HALF + 4);
#pragma unroll
                for (int ai = 0; ai < 2; ++ai)
#pragma unroll
                    for (int m = 0; m < 4; ++m) {
                        const int row = row0 + ai * HALF + m * 16;
                        f32x4 g0 = acc[ai][bj][m][0] + b0, g1 = acc[ai][bj][m][1] + b1;
#pragma unroll
                        for (int i = 0; i < 4; ++i) {
                            g0[i] = (fminf(g0[i], 0.f) - __logf(1.0f + __expf(-fabsf(g0[i])))) * 0.0625f;
                            g1[i] = (fminf(g1[i], 0.f) - __logf(1.0f + __expf(-fabsf(g1[i])))) * 0.0625f;
                        }
                        float* p = (float*)(ws + WS_LOGA) + (size_t)row * 512 + cgk + bj * HALF;
                        *(f32x4*)p = g0; *(f32x4*)(p + 4) = g1;
                    }
            }
        } else {
            const size_t off = pn < 9 ? WS_AG + (size_t)(pn - 5) * 512 : pn < 11 ? WS_BQ + (size_t)(pn - 9) * 512 : pn < 13 ? WS_BK + (size_t)(pn - 11) * 512 : pn < 17 ? WS_BV + (size_t)(pn - 13) * 512
                             : pn < 21 ? WS_AG + 2048 + (size_t)(pn - 17) * 512 : pn < 25 ? (size_t)(pn - 21) * 512 : (size_t)M * 2048 + (size_t)(pn - 25) * 512;
            const int ld = (pn >= 9 && pn < 13) ? 512 : (pn < 9 || (pn >= 17 && pn < 21)) ? 2048 : 1024; const int act = pn < 9 ? 1 : pn < 17 ? 0 : pn < 21 ? 1 : 2;
            bf16_t* base = (bf16_t*)((pn < 21 ? ws : outb) + off) + cl;
#pragma unroll
            for (int ai = 0; ai < 2; ++ai)
#pragma unroll
                for (int m = 0; m < 4; ++m) {
                    const int row = row0 + ai * HALF + m * 16;
#pragma unroll
                    for (int bj = 0; bj < 2; ++bj) {
                        f32x4 v0 = acc[ai][bj][m][0], v1 = acc[ai][bj][m][1];
                        if (act) {
#pragma unroll
                            for (int i = 0; i < 4; ++i) {
                                const float s0 = __builtin_amdgcn_rcpf(1.0f + __expf(-v0[i])), s1 = __builtin_amdgcn_rcpf(1.0f + __expf(-v1[i]));
                                v0[i] = act == 1 ? v0[i] * s0 : s0; v1[i] = act == 1 ? v1[i] * s1 : s1;
                            }
                        }
                        store8bf(base + (size_t)row * ld + bj * HALF, v0, v1);
                    }
                }
        }
    }
};
struct EpiScaleF32 {
    static constexpr bool PERM = true, AFTER_DRAIN = false;
    const bf16_t* G; float* Y;
    __device__ __forceinline__ void operator()(const f32x4 (&acc)[2][2][4][2], const Unit& u, int wr, int wc, int fr, int fq) const {
        const int row0 = u.pm * BM + wr * 64 + fr; const int col0 = u.pn * BM + wc * 32 + 8 * fq;
#pragma unroll
        for (int ai = 0; ai < 2; ++ai)
#pragma unroll
            for (int m = 0; m < 4; ++m) {
                const size_t ro = (size_t)(row0 + ai * HALF + m * 16) * 1024 + col0;
#pragma unroll
                for (int bj = 0; bj < 2; ++bj) {
                    f32x4 g0, g1; load8bf(G + ro + bj * HALF, g0, g1);
                    *(f32x4*)(Y + ro + bj * HALF) = acc[ai][bj][m][0] * g0; *(f32x4*)(Y + ro + bj * HALF + 4) = acc[ai][bj][m][1] * g1;
                }
            }
    }
};
struct EpiMerge {
    static constexpr bool PERM = true, AFTER_DRAIN = false;
    const bf16_t* G; const float* Y; bf16_t* O;
    __device__ __forceinline__ void operator()(const f32x4 (&acc)[2][2][4][2], const Unit& u, int wr, int wc, int fr, int fq) const {
        const int row0 = u.pm * BM + wr * 64 + fr; const int col0 = u.pn * BM + wc * 32 + 8 * fq;
#pragma unroll
        for (int ai = 0; ai < 2; ++ai)
#pragma unroll
            for (int m = 0; m < 4; ++m) {
                const size_t ro = (size_t)(row0 + ai * HALF + m * 16) * 1024 + col0;
#pragma unroll
                for (int bj = 0; bj < 2; ++bj) {
                    f32x4 g0, g1; load8bf(G + ro + bj * HALF, g0, g1);
                    const f32x4 y0 = *(const f32x4*)(Y + ro + bj * HALF), y1 = *(const f32x4*)(Y + ro + bj * HALF + 4);
                    store8bf(O + ro + bj * HALF, y0 + acc[ai][bj][m][0] * g0, y1 + acc[ai][bj][m][1] * g1);
                }
            }
    }
};
struct EpiOut {
    static constexpr bool PERM = true, AFTER_DRAIN = false;
    const float* X; float* O; float* SS;
    __device__ __forceinline__ void operator()(const f32x4 (&acc)[2][2][4][2], const Unit& u, int wr, int wc, int fr, int fq) const {
        const int row0 = u.pm * BM + wr * 64 + fr; const int col0 = u.pn * BM + wc * 32 + 8 * fq;
#pragma unroll
        for (int ai = 0; ai < 2; ++ai)
#pragma unroll
            for (int m = 0; m < 4; ++m) {
                const int row = row0 + ai * HALF + m * 16; const size_t ro = (size_t)row * 1024 + col0; float ss = 0.f;
#pragma unroll
                for (int bj = 0; bj < 2; ++bj) {
                    const f32x4 x0 = *(const f32x4*)(X + ro + bj * HALF), x1 = *(const f32x4*)(X + ro + bj * HALF + 4);
                    const f32x4 o0 = x0 + acc[ai][bj][m][0], o1 = x1 + acc[ai][bj][m][1];
                    *(f32x4*)(O + ro + bj * HALF) = o0; *(f32x4*)(O + ro + bj * HALF + 4) = o1;
                    ss += (o0[0] * o0[0] + o0[1] * o0[1]) + (o0[2] * o0[2] + o0[3] * o0[3]) + (o1[0] * o1[0] + o1[1] * o1[1]) + (o1[2] * o1[2] + o1[3] * o1[3]);
                }
                ss += __shfl_xor(ss, 16); ss += __shfl_xor(ss, 32);
                if (fq == 0) atomicAdd(SS + row, ss);
            }
    }
};

struct EpiOutNorm {
    static constexpr bool PERM = true, AFTER_DRAIN = true;
    const float* X; float* O; float* SS; unsigned* cnt; const float* fw;
    __device__ __forceinline__ void fused(f32x4 (&acc)[2][2][4][2], const Unit& u, int wr, int wc, int fr, int fq, PG8_LAS unsigned char* lds, int wid, int lane) const {
        const int row0 = u.pm * BM + wr * 64 + fr; const int col0 = u.pn * BM + wc * 32 + 8 * fq;
#pragma unroll
        for (int ai = 0; ai < 2; ++ai)
#pragma unroll
            for (int m = 0; m < 4; ++m) {
                const int row = row0 + ai * HALF + m * 16; const size_t ro = (size_t)row * 1024 + col0; float ss = 0.f;
#pragma unroll
                for (int bj = 0; bj < 2; ++bj) {
                    const f32x4 x0 = *(const f32x4*)(X + ro + bj * HALF), x1 = *(const f32x4*)(X + ro + bj * HALF + 4);
                    const f32x4 o0 = x0 + acc[ai][bj][m][0], o1 = x1 + acc[ai][bj][m][1];
                    acc[ai][bj][m][0] = o0; acc[ai][bj][m][1] = o1;
                    ss += (o0[0] * o0[0] + o0[1] * o0[1]) + (o0[2] * o0[2] + o0[3] * o0[3]) + (o1[0] * o1[0] + o1[1] * o1[1]) + (o1[2] * o1[2] + o1[3] * o1[3]);
                }
                ss += __shfl_xor(ss, 16); ss += __shfl_xor(ss, 32);
                if (fq == 0) __hip_atomic_fetch_add(SS + row, ss, __ATOMIC_RELAXED, __HIP_MEMORY_SCOPE_AGENT);
            }
        asm volatile("s_waitcnt vmcnt(0)" ::: "memory");
        __syncthreads();
        if (threadIdx.x == 0) {
            unsigned* c = cnt + 64 * u.pm;
            __hip_atomic_fetch_add(c, 1u, __ATOMIC_RELAXED, __HIP_MEMORY_SCOPE_AGENT);
            unsigned sp = 0;
            while (__hip_atomic_load(c, __ATOMIC_RELAXED, __HIP_MEMORY_SCOPE_AGENT) < 4u) { __builtin_amdgcn_s_sleep(2); if (++sp > (1u << 22)) break; }
        }
        __syncthreads();
        f32x4 w0[2], w1[2];
#pragma unroll
        for (int bj = 0; bj < 2; ++bj) { w0[bj] = *(const f32x4*)(fw + col0 + bj * HALF); w1[bj] = *(const f32x4*)(fw + col0 + bj * HALF + 4); }
#pragma unroll
        for (int ai = 0; ai < 2; ++ai)
#pragma unroll
            for (int m = 0; m < 4; ++m) {
                const int row = row0 + ai * HALF + m * 16; const size_t ro = (size_t)row * 1024 + col0;
                const float rstd = 1.0f / sqrtf(__hip_atomic_load(SS + row, __ATOMIC_RELAXED, __HIP_MEMORY_SCOPE_AGENT) * (1.0f / 1024.0f) + 1e-5f);
#pragma unroll
                for (int bj = 0; bj < 2; ++bj) {
                    *(f32x4*)(O + ro + bj * HALF) = acc[ai][bj][m][0] * rstd * w0[bj]; *(f32x4*)(O + ro + bj * HALF + 4) = acc[ai][bj][m][1] * rstd * w1[bj];
                }
            }
    }
};

struct EpiMerge2 {
    static constexpr bool PERM = true, AFTER_DRAIN = false;
    const bf16_t* GA; const bf16_t* GB; bf16_t* O;
    __device__ __forceinline__ void mid(f32x4 (&acc)[2][2][4][2], const Unit& u, int wr, int wc, int fr, int fq) const {
        const int row0 = u.pm * BM + wr * 64 + fr; const int col0 = u.pn * BM + wc * 32 + 8 * fq;
#pragma unroll
        for (int ai = 0; ai < 2; ++ai)
#pragma unroll
            for (int m = 0; m < 4; ++m) {
                const size_t ro = (size_t)(row0 + ai * HALF + m * 16) * 1024 + col0;
#pragma unroll
                for (int bj = 0; bj < 2; ++bj) {
                    f32x4 a0, a1, b0, b1; load8bf(GA + ro + bj * HALF, a0, a1); load8bf(GB + ro + bj * HALF, b0, b1);
#pragma unroll
                    for (int i = 0; i < 4; ++i) { acc[ai][bj][m][0][i] *= a0[i] * __builtin_amdgcn_rcpf(fmaxf(b0[i], 1e-30f)); acc[ai][bj][m][1][i] *= a1[i] * __builtin_amdgcn_rcpf(fmaxf(b1[i], 1e-30f)); }
                }
                asm volatile("" : "+v"(acc[ai][0][m][0]), "+v"(acc[ai][0][m][1]), "+v"(acc[ai][1][m][0]), "+v"(acc[ai][1][m][1]));
                if (m & 1) asm volatile("" ::: "memory");
            }
    }
    __device__ __forceinline__ void operator()(const f32x4 (&acc)[2][2][4][2], const Unit& u, int wr, int wc, int fr, int fq) const {
        if (u.seg == 0) { mid(const_cast<f32x4 (&)[2][2][4][2]>(acc), u, wr, wc, fr, fq); return; }
        const int row0 = u.pm * BM + wr * 64 + fr; const int col0 = u.pn * BM + wc * 32 + 8 * fq;
#pragma unroll
        for (int ai = 0; ai < 2; ++ai)
#pragma unroll
            for (int m = 0; m < 4; ++m) {
                const size_t ro = (size_t)(row0 + ai * HALF + m * 16) * 1024 + col0;
#pragma unroll
                for (int bj = 0; bj < 2; ++bj) {
                    f32x4 g0, g1; load8bf(GB + ro + bj * HALF, g0, g1);
                    store8bf(O + ro + bj * HALF, acc[ai][bj][m][0] * g0, acc[ai][bj][m][1] * g1);
                }
            }
    }
};
template <class Epi, class Sched, bool ALIGN_EPI = false, bool SP2 = false, bool MID = false>
__device__ __forceinline__ void gemm_phase(PG8_LAS unsigned char* lds, const Gemm g, const Sched& S, const Epi& E) {
    const int tid = threadIdx.x, wid = __builtin_amdgcn_readfirstlane(tid >> 6), lane = tid & 63, wr = wid >> 2, wc = wid & 3, fr = lane & 15, fq = lane >> 4;
    const int K = g.ld, nt = g.K / BK;
    const size_t segb = (size_t)g.K * 2;
    unsigned voffA[2], voffB[2];
#pragma unroll
    for (int i = 0; i < 2; ++i) { int R, C; stage_rc(tid * 16 + i * 8192, R, C); const int Rb = Epi::PERM ? ((R & ~31) + perm32(R & 31)) : R;
        voffA[i] = (unsigned)(R * K + C) * 2u; voffB[i] = (unsigned)(Rb * K + C) * 2u; }
    const size_t kstep = (size_t)(BK * 2);
    const size_t hstep = (size_t)HALF * K * 2;
    const size_t tstep = 2 * hstep;
    const unsigned ldsw = (unsigned)wid * 1024u;
    const int aoff = lds_byte(wr * 64 + fr, fq * 8), boff = lds_byte(wc * 32 + fr, fq * 8);
#define PG8_SA(b, h) (((b) * 2 + (h)) * HTB)
#define PG8_SB(b, h) ((4 + (b) * 2 + (h)) * HTB)
#define PG8_STAGE(bufoff, gbase, voff) do { _Pragma("unroll") for (int _i = 0; _i < 2; ++_i) \
        __builtin_amdgcn_global_load_lds((const unsigned*)((const char*)(gbase) + (voff)[_i]), (PG8_LAS unsigned*)(lds + (bufoff) + ldsw + _i * 8192), 16, 0, 0); } while (0)
#define PG8_LDA(dst, b, h) do { _Pragma("unroll") for (int m = 0; m < 4; ++m) _Pragma("unroll") for (int k = 0; k < 2; ++k) dst[m][k] = *(const PG8_LAS bf16x8*)(lds + PG8_SA(b, h) + aoff + m * 2048 + k * 1024); } while (0)
#define PG8_LDB(dst, b, h) do { _Pragma("unroll") for (int n = 0; n < 2; ++n) _Pragma("unroll") for (int k = 0; k < 2; ++k) dst[n][k] = *(const PG8_LAS bf16x8*)(lds + PG8_SB(b, h) + boff + n * 2048 + k * 1024); } while (0)
#define PG8_MMA(ai, bj, At, Bt) do { __builtin_amdgcn_s_setprio(1); _Pragma("unroll") for (int m = 0; m < 4; ++m) _Pragma("unroll") for (int n = 0; n < 2; ++n) _Pragma("unroll") for (int k = 0; k < 2; ++k) \
        acc[ai][bj][m][n] = __builtin_amdgcn_mfma_f32_16x16x32_bf16(Bt[n][k], At[m][k], acc[ai][bj][m][n], 0, 0, 0); __builtin_amdgcn_s_setprio(0); } while (0)
#define PG8_WAIT_V(n) asm volatile("s_waitcnt vmcnt(" #n ")" ::: "memory")
#define PG8_WAIT_L(n) asm volatile("s_waitcnt lgkmcnt(" #n ")" ::: "memory")
#define PG8_BAR __builtin_amdgcn_s_barrier()
#define PG8_SCHED __builtin_amdgcn_sched_barrier(0)
    Unit cur, nxt; int ui = 0;
    if (!S.next(0, cur)) return;
    f32x4 acc[2][2][4][2];
#pragma unroll
    for (int a = 0; a < 2; ++a)
#pragma unroll
        for (int b = 0; b < 2; ++b)
#pragma unroll
            for (int m = 0; m < 4; ++m)
#pragma unroll
                for (int n = 0; n < 2; ++n) acc[a][b][m][n] = (f32x4){0.f, 0.f, 0.f, 0.f};
    bf16x8 At[4][2], B0[2][2], B1[2][2];
    const char* cA = (const char*)g.A + (size_t)cur.pm * tstep + cur.seg * segb; const char* cB = (const char*)g.Bt + (size_t)cur.pn * tstep + cur.seg * segb;
    S.a_ready(cur);
    if constexpr (SP2) {
        PG8_STAGE(PG8_SB(0, 0), cB, voffB); PG8_STAGE(PG8_SB(0, 1), cB + hstep, voffB); PG8_STAGE(PG8_SA(0, 0), cA, voffA); PG8_STAGE(PG8_SA(0, 1), cA + hstep, voffA);
        if (wr == 1) PG8_BAR;
        PG8_WAIT_V(2); PG8_BAR;
        PG8_STAGE(PG8_SB(1, 0), cB + kstep, voffB); PG8_STAGE(PG8_SA(1, 0), cA + kstep, voffA); PG8_STAGE(PG8_SB(1, 1), cB + hstep + kstep, voffB);
        PG8_WAIT_V(6); PG8_BAR;
    } else {
        PG8_STAGE(PG8_SB(0, 0), cB, voffB); PG8_STAGE(PG8_SA(0, 0), cA, voffA); PG8_STAGE(PG8_SB(0, 1), cB + hstep, voffB); PG8_STAGE(PG8_SA(0, 1), cA + hstep, voffA);
        if (wr == 1) PG8_BAR;
        PG8_WAIT_V(4); PG8_BAR;
        PG8_STAGE(PG8_SB(1, 0), cB + kstep, voffB); PG8_STAGE(PG8_SA(1, 0), cA + kstep, voffA); PG8_STAGE(PG8_SB(1, 1), cB + hstep + kstep, voffB);
        PG8_WAIT_V(6); PG8_BAR;
    }
    for (;;) {
        const bool has_next = S.next(ui + 1, nxt);
        const char* nA = has_next ? (const char*)g.A + (size_t)nxt.pm * tstep + nxt.seg * segb : cA; const char* nB = has_next ? (const char*)g.Bt + (size_t)nxt.pn * tstep + nxt.seg * segb : cB;
        for (int t = 0; t < nt; t += 2) {
            const bool last = (t == nt - 2);
            const char* a1 = cA + (size_t)(t + 1) * kstep;
            const char* a2 = last ? nA : cA + (size_t)(t + 2) * kstep; const char* b2 = last ? nB : cB + (size_t)(t + 2) * kstep;
            const char* a3 = a2 + kstep; const char* b3 = b2 + kstep;
            if (last && has_next) S.a_ready(nxt);
            if constexpr (SP2) {
            PG8_LDB(B0, 0, 0); PG8_LDB(B1, 0, 1); PG8_SCHED; PG8_LDA(At, 0, 0); PG8_STAGE(PG8_SA(1, 1), a1 + hstep, voffA);
            PG8_WAIT_V(8); PG8_WAIT_L(0); PG8_BAR; PG8_MMA(0, 0, At, B0); PG8_MMA(0, 1, At, B1); PG8_BAR; PG8_SCHED;
            PG8_LDA(At, 0, 1); PG8_STAGE(PG8_SB(0, 0), b2, voffB); PG8_STAGE(PG8_SB(0, 1), b2 + hstep, voffB); PG8_STAGE(PG8_SA(0, 0), a2, voffA);
            PG8_WAIT_V(8); PG8_WAIT_L(0); PG8_BAR; PG8_MMA(1, 0, At, B0); PG8_MMA(1, 1, At, B1); PG8_BAR; PG8_SCHED;
            PG8_LDB(B0, 1, 0); PG8_LDB(B1, 1, 1); PG8_SCHED; PG8_LDA(At, 1, 0); PG8_STAGE(PG8_SA(0, 1), a2 + hstep, voffA);
            PG8_WAIT_V(8); PG8_WAIT_L(0); PG8_BAR; PG8_MMA(0, 0, At, B0); PG8_MMA(0, 1, At, B1); PG8_BAR; PG8_SCHED;
            PG8_LDA(At, 1, 1); PG8_STAGE(PG8_SB(1, 0), b3, voffB); PG8_STAGE(PG8_SB(1, 1), b3 + hstep, voffB); PG8_STAGE(PG8_SA(1, 0), a3, voffA);
            PG8_WAIT_V(8); PG8_WAIT_L(0); PG8_BAR; PG8_MMA(1, 0, At, B0); PG8_MMA(1, 1, At, B1); PG8_BAR; PG8_SCHED;
            } else {
            PG8_LDB(B0, 0, 0); PG8_SCHED; PG8_LDA(At, 0, 0); PG8_STAGE(PG8_SA(1, 1), a1 + hstep, voffA);
            PG8_WAIT_L(8); PG8_BAR; PG8_WAIT_L(0); PG8_MMA(0, 0, At, B0); PG8_BAR; PG8_SCHED;
            PG8_LDB(B1, 0, 1); PG8_STAGE(PG8_SB(0, 0), b2, voffB);
            PG8_BAR; PG8_WAIT_L(0); PG8_MMA(0, 1, At, B1); PG8_BAR;
            PG8_LDA(At, 0, 1); PG8_STAGE(PG8_SA(0, 0), a2, voffA);
            PG8_BAR; PG8_WAIT_L(0); PG8_MMA(1, 0, At, B0); PG8_BAR; PG8_SCHED;
            PG8_STAGE(PG8_SB(0, 1), b2 + hstep, voffB);
            PG8_WAIT_V(6); PG8_BAR; PG8_MMA(1, 1, At, B1); PG8_BAR;
            PG8_LDB(B0, 1, 0); PG8_SCHED; PG8_LDA(At, 1, 0); PG8_STAGE(PG8_SA(0, 1), a2 + hstep, voffA);
            PG8_WAIT_L(8); PG8_BAR; PG8_WAIT_L(0); PG8_MMA(0, 0, At, B0); PG8_BAR; PG8_SCHED;
            PG8_LDB(B1, 1, 1); PG8_STAGE(PG8_SB(1, 0), b3, voffB);
            PG8_BAR; PG8_WAIT_L(0); PG8_MMA(0, 1, At, B1); PG8_BAR;
            PG8_LDA(At, 1, 1); PG8_STAGE(PG8_SA(1, 0), a3, voffA);
            PG8_BAR; PG8_WAIT_L(0); PG8_MMA(1, 0, At, B0); PG8_BAR; PG8_SCHED;
            PG8_STAGE(PG8_SB(1, 1), b3 + hstep, voffB);
            PG8_WAIT_V(6); PG8_BAR; PG8_MMA(1, 1, At, B1); PG8_BAR;
            }
        }
        if constexpr (ALIGN_EPI) { if (wr == 0) PG8_BAR; }
        if constexpr (!Epi::AFTER_DRAIN) { E(acc, cur, wr, wc, fr, fq); S.done(cur); }
        if (!has_next) break;
        if (!(MID && cur.seg == 0))
#pragma unroll
        for (int a = 0; a < 2; ++a)
#pragma unroll
            for (int b = 0; b < 2; ++b)
#pragma unroll
                for (int m = 0; m < 4; ++m)
#pragma unroll
                    for (int n = 0; n < 2; ++n) acc[a][b][m][n] = (f32x4){0.f, 0.f, 0.f, 0.f};
        cur = nxt; cA = nA; cB = nB; ++ui;
        if constexpr (ALIGN_EPI) { if (wr == 1) PG8_BAR; }
    }
    PG8_WAIT_V(0);
    if constexpr (!ALIGN_EPI) { if (wr == 0) PG8_BAR; }
    PG8_BAR;
    if constexpr (Epi::AFTER_DRAIN) { E.fused(acc, cur, wr, wc, fr, fq, lds, wid, lane); S.done(cur); }
#undef PG8_SA
#undef PG8_SB
#undef PG8_STAGE
#undef PG8_LDA
#undef PG8_LDB
#undef PG8_MMA
#undef PG8_WAIT_V
#undef PG8_WAIT_L
#undef PG8_BAR
#undef PG8_SCHED
}
}
#define GAS __attribute__((address_space(1)))
#define LAS __attribute__((address_space(3)))
typedef unsigned short bf16;
typedef unsigned v4u __attribute__((ext_vector_type(4)));
typedef float f32x4 __attribute__((ext_vector_type(4)));
typedef short bf16x8 __attribute__((ext_vector_type(8)));
typedef GAS unsigned gu32;
typedef GAS unsigned long long gu64;
#define RLX_AGENT __ATOMIC_RELAXED, __HIP_MEMORY_SCOPE_AGENT
#define LDS_WAIT() asm volatile("s_waitcnt lgkmcnt(0)" ::: "memory")
#define VM_WAIT() asm volatile("s_waitcnt vmcnt(0)" ::: "memory")
__device__ __forceinline__ unsigned long long rt() { return __builtin_amdgcn_s_memrealtime(); }
__device__ __forceinline__ unsigned f2bf(float f) { unsigned u = __builtin_bit_cast(unsigned, f); return (u + 0x7fffu + ((u >> 16) & 1u)) >> 16; }
__device__ __forceinline__ unsigned pk2(float lo, float hi) { return f2bf(lo) | (f2bf(hi) << 16); }

#define XB_TMO      128
#define XB_XCNT(j)  (256  + 64 * (j))
#define XB_XSUB(j)  (1280 + 64 * (j))
#define XB_XGEN(j)  (2304 + 64 * (j))
#define XB_TOP      3328
#define XB_TOPGEN   3392
#define XCD_BAR_WORDS 3456
#define XB_SPIN_CAP (1u << 18)

__device__ __forceinline__ unsigned xb_ld(unsigned* p)              { return __hip_atomic_load(p, __ATOMIC_RELAXED, __HIP_MEMORY_SCOPE_AGENT); }
__device__ __forceinline__ unsigned xb_add(unsigned* p, unsigned v) { return __hip_atomic_fetch_add(p, v, __ATOMIC_RELAXED, __HIP_MEMORY_SCOPE_AGENT); }
__device__ __forceinline__ unsigned xb_xcc_id() { return (unsigned)__builtin_amdgcn_s_getreg((3 << 11) | 20) & 0xFu; }
#define XB_SPIN(cond, bar) do { unsigned _sp = 0; while (cond) { __builtin_amdgcn_s_sleep(1); \
    if ((++_sp & 255u) == 0u) { if (xb_ld(&(bar)[XB_TMO])) break; if (_sp > XB_SPIN_CAP) { atomicAdd(&(bar)[XB_TMO], 1u); break; } } } } while (0)

struct XcdBarrier {
    unsigned* bar; unsigned x;
    volatile LAS unsigned* st;
};

__device__ __forceinline__ XcdBarrier xcd_barrier_post(unsigned* bar, volatile LAS unsigned* st) {
    XcdBarrier b; b.bar = bar; b.x = xb_xcc_id(); b.st = st;
    if (threadIdx.x == 0) (void)xb_add(&bar[XB_XCNT(b.x)], 1u);
    return b;
}
__device__ __forceinline__ void xcd_barrier_complete(unsigned* bar, unsigned x, unsigned& nloc, unsigned& nx) {
    const unsigned G = gridDim.x * gridDim.y * gridDim.z;
    unsigned sum, cnt, mine, sp = 0u;
    for (;;) {
        sum = 0u; cnt = 0u; mine = 0u;
#pragma unroll
        for (unsigned j = 0; j < 16; ++j) { const unsigned c = xb_ld(&bar[XB_XCNT(j)]); sum += c; cnt += (c > 0u) ? 1u : 0u; mine = (j == x) ? c : mine; }
        if (sum == G) break;
        __builtin_amdgcn_s_sleep(1);
        if ((++sp & 255u) == 0u) { if (xb_ld(&bar[XB_TMO])) break; if (sp > XB_SPIN_CAP) { atomicAdd(&bar[XB_TMO], 1u); break; } }
    }
    nloc = mine > 0u ? mine : 1u; nx = cnt > 0u ? cnt : 1u;
}

__device__ __forceinline__ void xcd_barrier(const XcdBarrier& b) {
    asm volatile("s_waitcnt vmcnt(0)" ::: "memory");
    __syncthreads();
    if (threadIdx.x == 0) {
        unsigned* bar = b.bar;
        __builtin_amdgcn_s_waitcnt(0);
        unsigned nloc = b.st[0], nx = b.st[1];
        if (nloc == 0u) { xcd_barrier_complete(bar, b.x, nloc, nx); b.st[0] = nloc; b.st[1] = nx; }
        const unsigned old = xb_add(&bar[XB_XSUB(b.x)], 1u);
        const unsigned gen = old / nloc;
        if (old + 1u == (gen + 1u) * nloc) {
            __builtin_amdgcn_fence(__ATOMIC_RELEASE, "agent");
            asm volatile("s_waitcnt vmcnt(0)" ::: "memory");
            const unsigned og = xb_add(&bar[XB_TOP], 1u);
            const unsigned tg = og / nx;
            if (og + 1u == (tg + 1u) * nx) xb_add(&bar[XB_TOPGEN], 1u);
            else XB_SPIN(xb_ld(&bar[XB_TOPGEN]) == tg, bar);
            __builtin_amdgcn_fence(__ATOMIC_ACQUIRE, "agent");
            xb_add(&bar[XB_XGEN(b.x)], 1u);
            asm volatile("s_waitcnt vmcnt(0)" ::: "memory");
        } else {
            XB_SPIN(xb_ld(&bar[XB_XGEN(b.x)]) == gen, bar);
            __builtin_amdgcn_fence(__ATOMIC_ACQUIRE, "agent");
            asm volatile("s_waitcnt vmcnt(0)" ::: "memory");
        }
    }
    __syncthreads();
}
typedef unsigned u32x4 __attribute__((ext_vector_type(4)));

constexpr int RING_OFF = 0, RING_BYTES = 147456;
constexpr int LDSCTL_OFF = RING_BYTES, MISC_OFF = LDSCTL_OFF + 320;
constexpr int LDS_BYTES = RING_BYTES + 1024;

struct Frame {
    LAS unsigned char* lds;
    volatile LAS unsigned* MISC;
    int tid, lane, wave, vcu, G;
};

__device__ __forceinline__ float wave_sum(float v) {
#pragma unroll
    for (int o = 1; o < 64; o <<= 1) v += __shfl_xor(v, o);
    return v;
}
__device__ __forceinline__ int src_col_w1(int n) {
    if (n < 1152) { const int hh = n >> 6, p = n & 63; return hh * 64 + 4 * (p >> 3) + (p & 3) + 32 * ((p >> 2) & 1); }
    if (n < 5376) return n;
    return n + 16;
}
__device__ __forceinline__ void p0_transpose_item(const float* W, int ldw, int K, bf16* WT, int n0, int k0, int srccol, LAS float* scr, int lane) {
    float tv[32];
#pragma unroll
    for (int i = 0; i < 32; ++i) { const int kk = 2 * i + (lane >> 5); tv[i] = W[(size_t)(k0 + kk) * ldw + srccol]; }
#pragma unroll
    for (int i = 0; i < 32; ++i) { const int kk = 2 * i + (lane >> 5); scr[kk * 33 + (lane & 31)] = tv[i]; }
    LDS_WAIT(); asm volatile("" ::: "memory");
    const int c = lane & 7;
#pragma unroll
    for (int j = 0; j < 4; ++j) { const int n = (lane >> 3) + 8 * j; const LAS float* s = scr + (8 * c) * 33 + n;
        v4u o; o.x = pk2(s[0 * 33], s[1 * 33]); o.y = pk2(s[2 * 33], s[3 * 33]); o.z = pk2(s[4 * 33], s[5 * 33]); o.w = pk2(s[6 * 33], s[7 * 33]);
        *(GAS v4u*)(WT + (size_t)(n0 + n) * K + k0 + 8 * c) = o; }
    LDS_WAIT(); asm volatile("" ::: "memory");
}
__device__ __forceinline__ void p0_fold_item(const float* W, const float* up, bf16* WT, int e0, int k0, LAS float* scr, int lane) {
    float u[16];
#pragma unroll
    for (int r = 0; r < 16; ++r) u[r] = up[r * 512 + e0 + (lane & 31)];
#pragma unroll 4
    for (int i = 0; i < 32; ++i) { const int kk = 2 * i + (lane >> 5); const float* wr = W + (size_t)(k0 + kk) * INW + 5376; float a = 0.f;
#pragma unroll
        for (int r = 0; r < 16; ++r) a = fmaf(wr[r], u[r], a);
        scr[kk * 33 + (lane & 31)] = a; }
    LDS_WAIT(); asm volatile("" ::: "memory");
    const int c = lane & 7;
#pragma unroll
    for (int j = 0; j < 4; ++j) { const int n = (lane >> 3) + 8 * j; const LAS float* s = scr + (8 * c) * 33 + n;
        v4u o; o.x = pk2(s[0 * 33], s[1 * 33]); o.y = pk2(s[2 * 33], s[3 * 33]); o.z = pk2(s[4 * 33], s[5 * 33]); o.w = pk2(s[6 * 33], s[7 * 33]);
        *(GAS v4u*)(WT + (size_t)(7424 + e0 + n) * 1024 + k0 + 8 * c) = o; }
    LDS_WAIT(); asm volatile("" ::: "memory");
}
__device__ __forceinline__ void rms_row_to_bf16(int lane, const float* xrow, const float* w, bf16* orow) {
    const GAS f32x4* xr = (const GAS f32x4*)xrow + lane; const GAS f32x4* wr = (const GAS f32x4*)w + lane;
    f32x4 v[4]; float s = 0.f;
#pragma unroll
    for (int j = 0; j < 4; ++j) { v[j] = xr[64 * j]; s += (v[j].x * v[j].x + v[j].y * v[j].y) + (v[j].z * v[j].z + v[j].w * v[j].w); }
    const float rstd = 1.f / sqrtf(wave_sum(s) * (1.f / D) + EPS);
    GAS unsigned long long* o8 = (GAS unsigned long long*)orow + lane;
#pragma unroll
    for (int j = 0; j < 4; ++j) { const f32x4 ww = wr[64 * j];
        o8[64 * j] = (unsigned long long)pk2(v[j].x * rstd * ww.x, v[j].y * rstd * ww.y) | ((unsigned long long)pk2(v[j].z * rstd * ww.z, v[j].w * rstd * ww.w) << 32); }
}

__device__ __forceinline__ void rms_rows4_to_bf16(int lane, const float* x, const float* w, bf16* out, int m0, int stride) {
    f32x4 v[4][4]; float s[4];
#pragma unroll
    for (int r = 0; r < 4; ++r) { const int m = m0 + r * stride; const GAS f32x4* xr = (const GAS f32x4*)(x + (size_t)(m < M ? m : m0) * D) + lane;
#pragma unroll
        for (int j = 0; j < 4; ++j) v[r][j] = xr[64 * j]; }
    const GAS f32x4* wr = (const GAS f32x4*)w + lane;
    f32x4 ww[4];
#pragma unroll
    for (int j = 0; j < 4; ++j) ww[j] = wr[64 * j];
#pragma unroll
    for (int r = 0; r < 4; ++r) { float a = 0.f;
#pragma unroll
        for (int j = 0; j < 4; ++j) a += (v[r][j].x * v[r][j].x + v[r][j].y * v[r][j].y) + (v[r][j].z * v[r][j].z + v[r][j].w * v[r][j].w);
        s[r] = a; }
#pragma unroll
    for (int o = 1; o < 64; o <<= 1) {
#pragma unroll
        for (int r = 0; r < 4; ++r) s[r] += __shfl_xor(s[r], o); }
#pragma unroll
    for (int r = 0; r < 4; ++r) { const int m = m0 + r * stride; if (m < M) { const float rstd = 1.f / sqrtf(s[r] * (1.f / D) + EPS);
        GAS unsigned long long* o8 = (GAS unsigned long long*)(out + (size_t)m * D) + lane;
#pragma unroll
        for (int j = 0; j < 4; ++j) o8[64 * j] = (unsigned long long)pk2(v[r][j].x * rstd * ww[j].x, v[r][j].y * rstd * ww[j].y) | ((unsigned long long)pk2(v[r][j].z * rstd * ww[j].z, v[r][j].w * rstd * ww[j].w) << 32); } }
}
typedef float f32x16 __attribute__((ext_vector_type(16)));
typedef short s16x4 __attribute__((ext_vector_type(4)));
typedef unsigned u32x2 __attribute__((ext_vector_type(2)));
__device__ __forceinline__ int crow(int r, int hi) { return (r & 3) + 8 * (r >> 2) + 4 * hi; }
constexpr int AT_KSTR = 144, AT_VSTR = 520, AT_K = 0, AT_V = 256 * AT_KSTR, AT_W = AT_V + 64 * AT_VSTR, AT_WB = 2 * 32 * 144;
static_assert(AT_W + 8 * AT_WB <= RING_BYTES && (AT_W % 16) == 0, "attention LDS");
__device__ __forceinline__ void attn_unit(LAS unsigned char* lds, int b, int nb, int g, const bf16* Q, const bf16* KV, bf16* AGO, const float* sinks) {
    const int tid = threadIdx.x, lane = tid & 63, r32 = lane & 31, hi = lane >> 5; const int wid = __builtin_amdgcn_readfirstlane(tid >> 6);
    const long tok0 = (long)b * T + nb * 128, key0 = tok0 - 128;
    const int jlo = nb > 0 ? 0 : 128;
#pragma unroll
    for (int i = 0; i < 4; ++i) { const int p = tid + 512 * i, key = p >> 3, ch = p & 7;
        if (key >= jlo) { const v4u v = *(const GAS v4u*)(KV + (key0 + key) * 256 + g * 64 + ch * 8); *(LAS v4u*)(lds + AT_K + key * AT_KSTR + ch * 16) = v; } }
#pragma unroll
    for (int i = 0; i < 4; ++i) { const int p = tid + 512 * i, key = p & 255, ch = p >> 8;
        if (key >= jlo) { const v4u v = *(const GAS v4u*)(KV + (key0 + key) * 256 + 128 + g * 64 + ch * 8);
            LAS unsigned short* vt = (LAS unsigned short*)(lds + AT_V + (ch * 8) * AT_VSTR + key * 2);
            vt[0 * (AT_VSTR / 2)] = (unsigned short)(v.x & 0xffff); vt[1 * (AT_VSTR / 2)] = (unsigned short)(v.x >> 16);
            vt[2 * (AT_VSTR / 2)] = (unsigned short)(v.y & 0xffff); vt[3 * (AT_VSTR / 2)] = (unsigned short)(v.y >> 16);
            vt[4 * (AT_VSTR / 2)] = (unsigned short)(v.z & 0xffff); vt[5 * (AT_VSTR / 2)] = (unsigned short)(v.z >> 16);
            vt[6 * (AT_VSTR / 2)] = (unsigned short)(v.w & 0xffff); vt[7 * (AT_VSTR / 2)] = (unsigned short)(v.w >> 16); } }
    __syncthreads();
    const int hq = g * 8 + wid; const float sink2 = sinks[hq] * 1.4426950408889634f;
    const float NEG = -INFINITY;
    LAS unsigned char* wq = lds + AT_W + wid * AT_WB; LAS unsigned char* wg = wq + 32 * 144;
    const int srow = lane >> 3, spc = lane & 7;
    u32x4 qn[4], gn[4];
#pragma unroll
    for (int j = 0; j < 4; ++j) { const long rq = (tok0 + 8 * j + srow) * 1024 + hq * 64 + spc * 8, rg = (tok0 + 8 * j + srow) * 2048 + hq * 64 + spc * 8; qn[j] = *(const GAS u32x4*)(Q + rq); gn[j] = *(const GAS u32x4*)(AGO + rg); }
    for (int R = 0; R < 4; ++R) {
        const long qtok = tok0 + 32 * R + r32;
#pragma unroll
        for (int j = 0; j < 4; ++j) { *(LAS u32x4*)(wq + (8 * j + srow) * 144 + spc * 16) = qn[j]; *(LAS u32x4*)(wg + (8 * j + srow) * 144 + spc * 16) = gn[j]; }
        if (R < 3) {
#pragma unroll
            for (int j = 0; j < 4; ++j) { const long rq = (tok0 + 32 * (R + 1) + 8 * j + srow) * 1024 + hq * 64 + spc * 8, rg = (tok0 + 32 * (R + 1) + 8 * j + srow) * 2048 + hq * 64 + spc * 8; qn[j] = *(const GAS u32x4*)(Q + rq); gn[j] = *(const GAS u32x4*)(AGO + rg); }
        }
        bf16x8 qf[4];
#pragma unroll
        for (int s = 0; s < 4; ++s) qf[s] = *(const LAS bf16x8*)(wq + r32 * 144 + (16 * s + 8 * hi) * 2);
        f32x16 st[5];
#pragma unroll
        for (int tt = 0; tt < 5; ++tt) {
            const int Tt = R + tt; const bool active = (nb > 0) || (Tt >= 4);
#pragma unroll
            for (int r = 0; r < 16; ++r) st[tt][r] = 0.f;
            if (active) {
                bf16x8 kf4[4];
#pragma unroll
                for (int s = 0; s < 4; ++s) kf4[s] = *(const LAS bf16x8*)(lds + AT_K + (32 * Tt + r32) * AT_KSTR + (16 * s + 8 * hi) * 2);
                __builtin_amdgcn_s_setprio(1);
#pragma unroll
                for (int s = 0; s < 4; ++s) st[tt] = __builtin_amdgcn_mfma_f32_32x32x16_bf16(kf4[s], qf[s], st[tt], 0, 0, 0);
                __builtin_amdgcn_s_setprio(0);
            } else {
#pragma unroll
                for (int r = 0; r < 16; ++r) st[tt][r] = NEG;
            }
        }
#pragma unroll
        for (int r = 0; r < 16; ++r) { const int cr = crow(r, hi); if (!(cr > r32)) st[0][r] = NEG; if (!(cr <= r32)) st[4][r] = NEG; }
        float mx = sink2;
#pragma unroll
        for (int tt = 0; tt < 5; ++tt)
#pragma unroll
            for (int r = 0; r < 16; ++r) mx = fmaxf(mx, st[tt][r]);
        mx = fmaxf(mx, __shfl_xor(mx, 32));
        float l = 0.f;
#pragma unroll
        for (int tt = 0; tt < 5; ++tt)
#pragma unroll
            for (int r = 0; r < 16; ++r) { const float p = __builtin_amdgcn_exp2f(st[tt][r] - mx); st[tt][r] = p; l += p; }
        l += __shfl_xor(l, 32); l += __builtin_amdgcn_exp2f(sink2 - mx);
        const float inv_l = 1.0f / l;
        f32x16 o[2];
#pragma unroll
        for (int r = 0; r < 16; ++r) { o[0][r] = 0.f; o[1][r] = 0.f; }
#pragma unroll
        for (int tt = 0; tt < 5; ++tt) {
            const int Tt = R + tt; const bool active = (nb > 0) || (Tt >= 4);
            if (active) {
#pragma unroll
                for (int s = 0; s < 2; ++s) {
                    u32x4 pw; pw.x = pg8::cvt_pk_bf16(st[tt][8 * s + 0], st[tt][8 * s + 1]); pw.y = pg8::cvt_pk_bf16(st[tt][8 * s + 2], st[tt][8 * s + 3]);
                    pw.z = pg8::cvt_pk_bf16(st[tt][8 * s + 4], st[tt][8 * s + 5]); pw.w = pg8::cvt_pk_bf16(st[tt][8 * s + 6], st[tt][8 * s + 7]);
                    const bf16x8 pf = __builtin_bit_cast(bf16x8, pw);
#pragma unroll
                    for (int db = 0; db < 2; ++db) {
                        const LAS unsigned char* vp = lds + AT_V + (32 * db + r32) * AT_VSTR + (32 * Tt + 16 * s + 4 * hi) * 2;
                        const u32x2 a0 = *(const LAS u32x2*)vp, a1 = *(const LAS u32x2*)(vp + 16);
                        const u32x4 aw = (u32x4){a0.x, a0.y, a1.x, a1.y};
                        o[db] = __builtin_amdgcn_mfma_f32_32x32x16_bf16(__builtin_bit_cast(bf16x8, aw), pf, o[db], 0, 0, 0);
                    }
                }
            }
        }
#pragma unroll
        for (int db = 0; db < 2; ++db)
#pragma unroll
            for (int g4 = 0; g4 < 4; ++g4) {
                LAS u32x2* p = (LAS u32x2*)(wg + r32 * 144 + (32 * db + 8 * g4 + 4 * hi) * 2);
                const u32x2 gw = *p;
                u32x2 ow; ow.x = pg8::cvt_pk_bf16(o[db][4 * g4 + 0] * inv_l * pg8::bf_lo(gw.x), o[db][4 * g4 + 1] * inv_l * pg8::bf_hi(gw.x));
                ow.y = pg8::cvt_pk_bf16(o[db][4 * g4 + 2] * inv_l * pg8::bf_lo(gw.y), o[db][4 * g4 + 3] * inv_l * pg8::bf_hi(gw.y));
                *p = ow;
            }
#pragma unroll
        for (int j = 0; j < 4; ++j) { const u32x4 v = *(const LAS u32x4*)(wg + (8 * j + srow) * 144 + spc * 16);
            *(GAS u32x4*)(AGO + (tok0 + 32 * R + 8 * j + srow) * 2048 + hq * 64 + spc * 8) = v; }
    }
    __syncthreads();
}

typedef float f32x2 __attribute__((ext_vector_type(2)));
constexpr int G1_QSTR = 272;
constexpr int G1_QE = 0, G1_KE = G1_QE + 64 * G1_QSTR, G1_SEG = G1_KE + 64 * G1_QSTR, G1_END = G1_SEG + 4096;
struct PSet { f32x2 la2[8]; unsigned q2[8], k2[8]; };
__device__ __forceinline__ void pset_load(PSet& p, int b, int h, int n, int w, int c2, const bf16* BQ, const bf16* BK, const float* LOGA) {
    const long tk = (long)b * T + n * 64;
#pragma unroll
    for (int i = 0; i < 8; ++i) { const long ro = (tk + 8 * w + i) * 512 + h * 128 + 2 * c2;
        p.la2[i] = *(const GAS f32x2*)(LOGA + ro); p.q2[i] = *(const GAS unsigned*)(BQ + ro); p.k2[i] = *(const GAS unsigned*)(BK + ro); }
}
__device__ __forceinline__ void gla_pre_item(PSet& p, LAS unsigned char* lds, int bh, int n, bf16* BQ, bf16* BK, bf16* ATTG, float* DECG) {
    const int tid = threadIdx.x, lane = tid & 63, r32 = lane & 31, hi = lane >> 5; const int w = __builtin_amdgcn_readfirstlane(tid >> 6);
    const int b = bh >> 2, h = bh & 3, c2 = tid & 63;
    LAS f32x2* SEG = (LAS f32x2*)(lds + G1_SEG);
    const long tokc = (long)b * T + n * 64;
#pragma unroll
    for (int i = 1; i < 8; ++i) p.la2[i] += p.la2[i - 1];
    SEG[w * 64 + c2] = p.la2[7];
    __syncthreads();
    f32x2 off = (f32x2){0.f, 0.f}, bl = (f32x2){0.f, 0.f};
#pragma unroll
    for (int s = 0; s < 8; ++s) { const f32x2 v = SEG[s * 64 + c2]; bl += v; if (s < w) off += v; }
    const float decx = __expf(bl.x), decy = __expf(bl.y);
    if (w == 0) __hip_atomic_store((unsigned long long*)(DECG + ((long)bh * 32 + n) * 128 + 2 * c2), ((unsigned long long)__float_as_uint(decy) << 32) | __float_as_uint(decx), __ATOMIC_RELAXED, __HIP_MEMORY_SCOPE_AGENT);
#pragma unroll
    for (int i = 0; i < 8; ++i) {
        const float bx = off.x + p.la2[i].x, by = off.y + p.la2[i].y;
        const float ex = __expf(bx), ey = __expf(by), iex = __builtin_amdgcn_rcpf(ex), iey = __builtin_amdgcn_rcpf(ey);
        const float qx = pg8::bf_lo(p.q2[i]) * 0.08838834764831845f * ex, qy = pg8::bf_hi(p.q2[i]) * 0.08838834764831845f * ey;
        const float kx = pg8::bf_lo(p.k2[i]) * iex, ky = pg8::bf_hi(p.k2[i]) * iey;
        const unsigned qw = pg8::cvt_pk_bf16(qx, qy);
        const long ro = (tokc + 8 * w + i) * 512 + h * 128 + 2 * c2;
        *(LAS unsigned*)(lds + G1_QE + (8 * w + i) * G1_QSTR + c2 * 4) = qw;
        *(LAS unsigned*)(lds + G1_KE + (8 * w + i) * G1_QSTR + c2 * 4) = pg8::cvt_pk_bf16(kx, ky);
        __hip_atomic_store((unsigned*)(BQ + ro), qw, __ATOMIC_RELAXED, __HIP_MEMORY_SCOPE_AGENT);
        __hip_atomic_store((unsigned*)(BK + ro), pg8::cvt_pk_bf16(kx * decx, ky * decy), __ATOMIC_RELAXED, __HIP_MEMORY_SCOPE_AGENT);
    }
    __syncthreads();
    if (w < 3) {
        const int Ia = (w + 1) >> 1, Ja = w >> 1;
        f32x16 a;
#pragma unroll
        for (int r = 0; r < 16; ++r) a[r] = 0.f;
#pragma unroll
        for (int s = 0; s < 8; ++s) {
            const bf16x8 kf = *(const LAS bf16x8*)(lds + G1_KE + (32 * Ja + r32) * G1_QSTR + (16 * s + 8 * hi) * 2);
            const bf16x8 qf = *(const LAS bf16x8*)(lds + G1_QE + (32 * Ia + r32) * G1_QSTR + (16 * s + 8 * hi) * 2);
            a = __builtin_amdgcn_mfma_f32_32x32x16_bf16(kf, qf, a, 0, 0, 0);
        }
        bf16* ap = ATTG + (((long)bh * 32 + n) * 64 + 32 * Ia + r32) * 64 + 32 * Ja + 4 * hi;
#pragma unroll
        for (int g4 = 0; g4 < 4; ++g4) {
            float v[4];
#pragma unroll
            for (int e = 0; e < 4; ++e) { const int jj = 32 * Ja + 8 * g4 + 4 * hi + e, ii = 32 * Ia + r32; v[e] = (jj <= ii) ? a[4 * g4 + e] : 0.f; }
            u32x2 ow; ow.x = pg8::cvt_pk_bf16(v[0], v[1]); ow.y = pg8::cvt_pk_bf16(v[2], v[3]);
            __hip_atomic_store((unsigned long long*)(ap + 8 * g4), ((unsigned long long)ow.y << 32) | ow.x, __ATOMIC_RELAXED, __HIP_MEMORY_SCOPE_AGENT);
        }
    }
    __syncthreads();
}
__device__ __forceinline__ void gla_pre(LAS unsigned char* lds, int bh, int n0, int cnt, bf16* BQ, bf16* BK, const float* LOGA, bf16* ATTG, float* DECG) {
    const int tid = threadIdx.x; const int w = __builtin_amdgcn_readfirstlane(tid >> 6); const int b = bh >> 2, h = bh & 3, c2 = tid & 63;
    PSet A, B;
    pset_load(A, b, h, n0, w, c2, BQ, BK, LOGA);
    for (int j = 0; j < cnt; j += 2) {
        if (j + 1 < cnt) pset_load(B, b, h, n0 + j + 1, w, c2, BQ, BK, LOGA);
        gla_pre_item(A, lds, bh, n0 + j, BQ, BK, ATTG, DECG);
        if (j + 1 < cnt) {
            if (j + 2 < cnt) pset_load(A, b, h, n0 + j + 2, w, c2, BQ, BK, LOGA);
            gla_pre_item(B, lds, bh, n0 + j + 1, BQ, BK, ATTG, DECG);
        }
    }
}
constexpr int G2_TSTR = 144, G2_QSTR = 272;
constexpr int G2_KST = 0, G2_VT = G2_KST + 128 * G2_TSTR, G2_QE = G2_VT + 32 * G2_TSTR, G2_ATT = G2_QE + 64 * G2_QSTR, G2_OP = G2_ATT + 64 * G2_TSTR, G2_SSQ = G2_OP + 32768, G2_END = G2_SSQ + 1024;
static_assert(G2_END <= RING_BYTES && (G2_QE % 16) == 0 && (G2_ATT % 16) == 0 && (G2_OP % 16) == 0 && G1_END <= RING_BYTES, "GLA LDS");
#ifdef PROBE_PHASE
#define GLA_T(k) do { if (blockIdx.x == 0 && c.tid == 0) { const unsigned t_ = (unsigned)__builtin_amdgcn_s_memrealtime(); volatile LAS unsigned* M_ = (volatile LAS unsigned*)(lds + MISC_OFF); \
        if ((k) > 0) M_[26 + (k)] += t_ - M_[26]; M_[26] = t_; } } while (0)
#else
#define GLA_T(k) do {} while (0)
#endif
struct GSet { unsigned ks2[8]; u32x2 vq; u32x4 qe[2]; u32x4 att; f32x4 dec[4]; };
struct GCtx { const bf16* QE; const bf16* KS; const bf16* BV; const bf16* ATTG; const float* DECG; bf16* OBU; float* SSB; int bh, sl, b, h, kb, I, c2, vtok, vd4, w, lane, r32, hi, tid; bool has_intra; };
__device__ __forceinline__ void gset_load(GSet& s, const GCtx& c, int n) {
    const long tk = (long)c.b * T + n * 64; const long it = (long)c.bh * 32 + n;
    s.vq = *(const GAS u32x2*)(c.BV + (tk + c.vtok) * 1024 + c.h * 256 + 32 * c.sl + c.vd4);
#pragma unroll
    for (int i = 0; i < 8; ++i) s.ks2[i] = *(const GAS unsigned*)(c.KS + (tk + 8 * c.w + i) * 512 + c.h * 128 + 2 * c.c2);
#pragma unroll
    for (int j = 0; j < 2; ++j) { const int p = c.tid + 512 * j; s.qe[j] = *(const GAS u32x4*)(c.QE + (tk + (p >> 4)) * 512 + c.h * 128 + (p & 15) * 8); }
    s.att = *(const GAS u32x4*)(c.ATTG + (it * 64 + (c.tid >> 3)) * 64 + (c.tid & 7) * 8);
#pragma unroll
    for (int g = 0; g < 4; ++g) s.dec[g] = *(const GAS f32x4*)(c.DECG + it * 128 + 32 * c.kb + 8 * g + 4 * c.hi);
}
__device__ __forceinline__ void gla_chunk(GSet& s, const GCtx& c, int n, f32x16& S, LAS unsigned char* lds) {
    const long tokc = (long)c.b * T + n * 64;
    LAS unsigned char* buf = lds;
    LAS float* SSQ = (LAS float*)(lds + G2_SSQ);
    const int kb = c.kb, I = c.I, r32 = c.r32, hi = c.hi, lane = c.lane;
    u32x4 sw[2];
#pragma unroll
    for (int s2 = 0; s2 < 2; ++s2) { sw[s2].x = pg8::cvt_pk_bf16(S[8 * s2 + 0], S[8 * s2 + 1]); sw[s2].y = pg8::cvt_pk_bf16(S[8 * s2 + 2], S[8 * s2 + 3]);
        sw[s2].z = pg8::cvt_pk_bf16(S[8 * s2 + 4], S[8 * s2 + 5]); sw[s2].w = pg8::cvt_pk_bf16(S[8 * s2 + 6], S[8 * s2 + 7]); }
#pragma unroll
    for (int r = 0; r < 16; ++r) S[r] *= s.dec[r >> 2][r & 3];
    asm volatile("" : "+v"(S));
    GLA_T(0);
    {
        v4u kx, ky;
        kx.x = (s.ks2[0] & 0xffffu) | (s.ks2[1] << 16); kx.y = (s.ks2[2] & 0xffffu) | (s.ks2[3] << 16); kx.z = (s.ks2[4] & 0xffffu) | (s.ks2[5] << 16); kx.w = (s.ks2[6] & 0xffffu) | (s.ks2[7] << 16);
        ky.x = (s.ks2[0] >> 16) | (s.ks2[1] & 0xffff0000u); ky.y = (s.ks2[2] >> 16) | (s.ks2[3] & 0xffff0000u); ky.z = (s.ks2[4] >> 16) | (s.ks2[5] & 0xffff0000u); ky.w = (s.ks2[6] >> 16) | (s.ks2[7] & 0xffff0000u);
        *(LAS v4u*)(buf + G2_KST + (2 * c.c2) * G2_TSTR + 16 * c.w) = kx;
        *(LAS v4u*)(buf + G2_KST + (2 * c.c2 + 1) * G2_TSTR + 16 * c.w) = ky;
        LAS unsigned short* vt = (LAS unsigned short*)(buf + G2_VT + c.vd4 * G2_TSTR + c.vtok * 2);
        vt[0] = (unsigned short)(s.vq.x & 0xffff); vt[G2_TSTR / 2] = (unsigned short)(s.vq.x >> 16);
        vt[2 * (G2_TSTR / 2)] = (unsigned short)(s.vq.y & 0xffff); vt[3 * (G2_TSTR / 2)] = (unsigned short)(s.vq.y >> 16);
#pragma unroll
        for (int j = 0; j < 2; ++j) { const int p = c.tid + 512 * j; *(LAS u32x4*)(buf + G2_QE + (p >> 4) * G2_QSTR + (p & 15) * 16) = s.qe[j]; }
        *(LAS u32x4*)(buf + G2_ATT + (c.tid >> 3) * G2_TSTR + (c.tid & 7) * 16) = s.att;
    }
    __syncthreads();
    GLA_T(1);
    if (n > 0 && c.tid < 64) { const float q = (SSQ[c.tid] + SSQ[64 + c.tid]) + (SSQ[128 + c.tid] + SSQ[192 + c.tid]);
        __hip_atomic_fetch_add(c.SSB + (tokc - 64 + c.tid) * 4 + c.h, q, __ATOMIC_RELAXED, __HIP_MEMORY_SCOPE_AGENT); }
    f32x16 oT;
#pragma unroll
    for (int r = 0; r < 16; ++r) oT[r] = 0.f;
#pragma unroll
    for (int s2 = 0; s2 < 2; ++s2) {
        const LAS unsigned char* qp = buf + G2_QE + (32 * I + r32) * G2_QSTR + (32 * kb + 16 * s2 + 4 * hi) * 2;
        const u32x2 a0 = *(const LAS u32x2*)qp, a1 = *(const LAS u32x2*)(qp + 16);
        const u32x4 qw = (u32x4){a0.x, a0.y, a1.x, a1.y};
        oT = __builtin_amdgcn_mfma_f32_32x32x16_bf16(__builtin_bit_cast(bf16x8, sw[s2]), __builtin_bit_cast(bf16x8, qw), oT, 0, 0, 0);
    }
    bf16x8 vf[4];
#pragma unroll
    for (int k = 0; k < 4; ++k) vf[k] = *(const LAS bf16x8*)(buf + G2_VT + r32 * G2_TSTR + (16 * k + 8 * hi) * 2);
#pragma unroll
    for (int k = 0; k < 4; ++k) {
        const bf16x8 kf = *(const LAS bf16x8*)(buf + G2_KST + (32 * kb + r32) * G2_TSTR + (16 * k + 8 * hi) * 2);
        S = __builtin_amdgcn_mfma_f32_32x32x16_bf16(kf, vf[k], S, 0, 0, 0);
    }
    if (c.has_intra) {
        const bf16x8 vk = *(const LAS bf16x8*)(buf + G2_VT + r32 * G2_TSTR + (16 * kb + 8 * hi) * 2);
        const bf16x8 af = *(const LAS bf16x8*)(buf + G2_ATT + (32 * I + r32) * G2_TSTR + (16 * kb + 8 * hi) * 2);
        oT = __builtin_amdgcn_mfma_f32_32x32x16_bf16(vk, af, oT, 0, 0, 0);
    }
    if (n + 2 < 32) gset_load(s, c, n + 2);
#pragma unroll
    for (int g4 = 0; g4 < 4; ++g4) *(LAS f32x4*)(lds + G2_OP + (((kb * 2 + I) * 4 + g4) * 64 + lane) * 16) = (f32x4){oT[4 * g4], oT[4 * g4 + 1], oT[4 * g4 + 2], oT[4 * g4 + 3]};
    __syncthreads();
    GLA_T(2);
    f32x4 v = *(const LAS f32x4*)(lds + G2_OP + (((0 * 2 + I) * 4 + kb) * 64 + lane) * 16);
#pragma unroll
    for (int kw = 1; kw < 4; ++kw) v += *(const LAS f32x4*)(lds + G2_OP + (((kw * 2 + I) * 4 + kb) * 64 + lane) * 16);
    { u32x2 ow; ow.x = pg8::cvt_pk_bf16(v[0], v[1]); ow.y = pg8::cvt_pk_bf16(v[2], v[3]);
      __hip_atomic_store((unsigned long long*)(c.OBU + (tokc + 32 * I + r32) * 1024 + c.h * 256 + 32 * c.sl + 8 * kb + 4 * hi), ((unsigned long long)ow.y << 32) | ow.x, __ATOMIC_RELAXED, __HIP_MEMORY_SCOPE_AGENT); }
    float ss = (v[0] * v[0] + v[1] * v[1]) + (v[2] * v[2] + v[3] * v[3]);
    ss += __shfl_xor(ss, 32);
    if (hi == 0) SSQ[kb * 64 + 32 * I + r32] = ss;
    GLA_T(3);
}
__device__ __forceinline__ void gla_serial(LAS unsigned char* lds, int bh, int sl, const bf16* QE, const bf16* KS, const bf16* BV, const bf16* ATTG, const float* DECG, bf16* OBU, float* SSB) {
    GCtx c; c.QE = QE; c.KS = KS; c.BV = BV; c.ATTG = ATTG; c.DECG = DECG; c.OBU = OBU; c.SSB = SSB; c.bh = bh; c.sl = sl; c.b = bh >> 2; c.h = bh & 3;
    c.tid = threadIdx.x; c.lane = c.tid & 63; c.r32 = c.lane & 31; c.hi = c.lane >> 5; c.w = __builtin_amdgcn_readfirstlane(c.tid >> 6);
    c.kb = c.w & 3; c.I = c.w >> 2; c.c2 = c.tid & 63; c.vtok = c.tid >> 3; c.vd4 = (c.tid & 7) * 4; c.has_intra = (c.I == 1) || (c.kb < 2);
    f32x16 S;
#pragma unroll
    for (int r = 0; r < 16; ++r) S[r] = 0.f;
    GSet A, B;
    gset_load(A, c, 0); gset_load(B, c, 1);
    for (int n = 0; n < 32; n += 2) { gla_chunk(A, c, n, S, lds); gla_chunk(B, c, n + 1, S, lds); }
    __syncthreads();
    LAS float* SSQ = (LAS float*)(lds + G2_SSQ);
    if (c.tid < 64) { const float q = (SSQ[c.tid] + SSQ[64 + c.tid]) + (SSQ[128 + c.tid] + SSQ[192 + c.tid]);
        __hip_atomic_fetch_add(SSB + ((long)c.b * T + 31 * 64 + c.tid) * 4 + c.h, q, __ATOMIC_RELAXED, __HIP_MEMORY_SCOPE_AGENT); }
    __syncthreads();
}

__device__ __forceinline__ void gla_norm_rows(int bh, int t0, int cnt, int wave, int nwaves, int lane, const bf16* OBU, bf16* BG, const float* SSB, const float* nw) {
    const int b = bh >> 2, h = bh & 3;
    const f32x4 w4 = *(const GAS f32x4*)(nw + 4 * lane);
    constexpr int NB = 16;
    for (int tb = t0 + wave; tb < t0 + cnt; tb += nwaves * NB) {
        float ssv[NB]; u32x2 ov[NB], gv[NB];
#pragma unroll
        for (int j = 0; j < NB; ++j) { const int t = tb + j * nwaves; const long tok = (long)b * T + (t < t0 + cnt ? t : t0);
            ssv[j] = __hip_atomic_load(SSB + tok * 4 + h, __ATOMIC_RELAXED, __HIP_MEMORY_SCOPE_AGENT);
            ov[j] = *(const GAS u32x2*)(OBU + tok * 1024 + h * 256 + 4 * lane); gv[j] = *(const GAS u32x2*)(BG + tok * 2048 + h * 256 + 4 * lane); }
#pragma unroll
        for (int j = 0; j < NB; ++j) { const int t = tb + j * nwaves;
            if (t < t0 + cnt) { const long tok = (long)b * T + t;
                const float rstd = 1.0f / sqrtf(ssv[j] * (1.0f / 256.0f) + EPS);
                u32x2 r; r.x = pg8::cvt_pk_bf16(pg8::bf_lo(ov[j].x) * rstd * w4[0] * pg8::bf_lo(gv[j].x), pg8::bf_hi(ov[j].x) * rstd * w4[1] * pg8::bf_hi(gv[j].x));
                r.y = pg8::cvt_pk_bf16(pg8::bf_lo(ov[j].y) * rstd * w4[2] * pg8::bf_lo(gv[j].y), pg8::bf_hi(ov[j].y) * rstd * w4[3] * pg8::bf_hi(gv[j].y));
                *(GAS u32x2*)(BG + tok * 2048 + h * 256 + 4 * lane) = r; } }
    }
}
struct Args { const float* in[12]; float* out; unsigned char* ws; int ph_lo, ph_hi, use_cg, dummy; };
constexpr int N_PHASES = 7;
__global__ void __launch_bounds__(NWAVES * 64, 2) hybrid_fwd(Args args) {
    extern __shared__ __attribute__((aligned(16))) unsigned char lds[];
    Frame F;
    F.lds = (LAS unsigned char*)lds;
    F.MISC = (volatile LAS unsigned*)(F.lds + MISC_OFF);
    F.tid = threadIdx.x; F.lane = F.tid & 63; F.wave = __builtin_amdgcn_readfirstlane(F.tid >> 6);
    F.G = gridDim.x; { const int bx = blockIdx.x; F.vcu = (F.G % 8 == 0) ? (bx % 8) * (F.G / 8) + bx / 8 : bx; }
    unsigned char* ws = args.ws;
    gu32* ctl = (gu32*)(ws + WS_CTL);
    const float* x = args.in[0]; const int* positions = (const int*)args.in[1]; const float* norm_w = args.in[2]; const float* w_in = args.in[3];
    const float* a_sinks = args.in[4]; const float* b_gate_up = args.in[5]; const float* b_gate_bias = args.in[6]; const float* b_out_norm_w = args.in[7];
    const float* w_a_proj = args.in[8]; const float* w_b_proj = args.in[9]; const float* w_out = args.in[10]; const float* final_norm_w = args.in[11];
    bf16* W1t = (bf16*)(ws + WS_W1); bf16* Wabt = (bf16*)(ws + WS_WA);     bf16* Wot = (bf16*)(ws + WS_WO);
    bf16* XN = (bf16*)(ws + WS_XN); bf16* Qb = (bf16*)(ws + WS_Q); bf16* KVb = (bf16*)(ws + WS_KV); bf16* BQb = (bf16*)(ws + WS_BQ); bf16* BKb = (bf16*)(ws + WS_BK);
    bf16* BVb = (bf16*)(ws + WS_BV); bf16* AGb = (bf16*)(ws + WS_AG); bf16* BGb = AGb + 1024;     float* LOGA = (float*)(ws + WS_LOGA);
    float* YA = (float*)(ws + WS_YA); bf16* MERGED = XN; bf16* OBU = XN; float* SS2 = (float*)(ws + WS_SS2); float* SSB = (float*)(ws + WS_SSB);
    bf16* MAb = (bf16*)args.out; bf16* MBb = MAb + (size_t)M * 1024;
    for (int u = F.tid; u < (LDS_BYTES - LDSCTL_OFF) / 4; u += NWAVES * 64) ((LAS unsigned*)(F.lds + LDSCTL_OFF))[u] = 0u;
    __syncthreads();
    XcdBarrier bar = xcd_barrier_post((unsigned*)(ctl + CW_BAR), F.MISC + 8);
    const int lo = args.ph_lo, hi = args.ph_hi;
#define IN(k) (lo <= (k) && (k) < hi)
#define BOTH(k) (IN(k) && IN((k) + 1))
#define GRID_BAR() do { if (args.use_cg) cg::this_grid().sync(); else xcd_barrier(bar); } while (0)
#ifdef PROBE_PHASE
#define STAMP(k) do { if (blockIdx.x == 0 && F.tid == 0) F.MISC[16 + (k)] = (unsigned)__builtin_amdgcn_s_memrealtime(); } while (0)
    STAMP(0);
#else
#define STAMP(k) do {} while (0)
#endif

    if (IN(0)) {
        LAS float* scr = (LAS float*)(F.lds + RING_OFF + F.wave * 16384);
        const int gw = F.vcu * NWAVES + F.wave, NGW = F.G * NWAVES;
        constexpr int I_1 = 16 * (7424 / 32), I_F = 16 * (512 / 32), I_S = 16 * 32;
        constexpr int NITEMS = I_1 + I_F;
        for (int it = gw; it < NITEMS; it += NGW) {
            int r = it;
            if (r < I_1) { const int kb = r / 232, nb = r % 232; p0_transpose_item(w_in, INW, 1024, W1t, 32 * nb, 64 * kb, src_col_w1(32 * nb + (F.lane & 31)), scr, F.lane); continue; } r -= I_1;
            { const int kb = r / 16, eb = r % 16; p0_fold_item(w_in, b_gate_up, W1t, 32 * eb, 64 * kb, scr, F.lane); }
        }
        for (int m = gw; m < M; m += 4 * NGW) rms_rows4_to_bf16(F.lane, x, norm_w, XN, m, NGW);
        for (int i = blockIdx.x * 512 + F.tid; i < M; i += F.G * 512) SS2[i] = 0.f;
        for (int i = blockIdx.x * 512 + F.tid; i < M * 4; i += F.G * 512) SSB[i] = 0.f;
        if (BOTH(0)) GRID_BAR();
        STAMP(1);
    }
    if (IN(1)) {
        const int n_full = (F.G == 256) ? 192 : 0;
        if ((int)blockIdx.x >= n_full) {
            LAS float* scr = (LAS float*)(F.lds + RING_OFF + F.wave * 16384);
            const int nb2 = F.G - n_full; const int gw2 = ((int)blockIdx.x - n_full) * NWAVES + F.wave, NGW2 = nb2 * NWAVES;
            constexpr int I_S = 16 * 32;
            for (int it = gw2; it < 3 * I_S; it += NGW2) {
                int r = it; const int mat = r / I_S; r -= mat * I_S; const int kb = r / 32, nb = r % 32;
                const float* Wsrc = mat == 0 ? w_a_proj : (mat == 1 ? w_b_proj : w_out); bf16* Wdst = mat == 0 ? Wabt : (mat == 1 ? Wabt + 1024 : Wot);
                p0_transpose_item(Wsrc, 1024, mat == 2 ? 1024 : 2048, Wdst, 32 * nb, 64 * kb, 32 * nb + (F.lane & 31), scr, F.lane);
            }
            asm volatile("s_waitcnt vmcnt(0) lgkmcnt(0)" ::: "memory");
#ifdef STAGGER_TICKS
            { const unsigned long long t0 = __builtin_amdgcn_s_memrealtime(); while (__builtin_amdgcn_s_memrealtime() - t0 < STAGGER_TICKS) __builtin_amdgcn_s_sleep(8); }
#endif
            __syncthreads();
        }
        pg8::Gemm g{XN, W1t, M, N1, D, D}; pg8::StaticOrder S; S.init(M, N1, F.G, (int)blockIdx.x);
        pg8::EpiP1 E{ws, (unsigned char*)args.out, positions, b_gate_bias};
        pg8::gemm_phase<pg8::EpiP1, pg8::StaticOrder, true, true>(F.lds + RING_OFF, g, S, E);
        if (BOTH(1)) GRID_BAR();
        STAMP(2);
    }
    if (IN(2)) {
        bf16* ATTG = (bf16*)(ws + WS_W1); float* DECG = (float*)(ws + WS_W1 + 8 * MiB);
        if (F.G == 256) {
            const int bh = F.vcu >> 3, sl = F.vcu & 7;
            unsigned* gc = (unsigned*)(ctl + CW_GLA + 64 * bh);
            const int au = F.vcu;
            const bool serial_first = (bh & 1) != 0;
            if (!serial_first && (F.vcu & 1)) attn_unit(F.lds + RING_OFF, au >> 5, (au >> 1) & 15, au & 1, Qb, KVb, AGb, a_sinks);
            gla_pre(F.lds + RING_OFF, bh, 4 * sl, 4, BQb, BKb, LOGA, ATTG, DECG);
            asm volatile("s_waitcnt vmcnt(0)" ::: "memory");
            __syncthreads();
            if (F.tid == 0) { __hip_atomic_fetch_add(gc, 1u, __ATOMIC_RELAXED, __HIP_MEMORY_SCOPE_AGENT); }
            STAMP(8);
            if (!serial_first && !(F.vcu & 1)) attn_unit(F.lds + RING_OFF, au >> 5, (au >> 1) & 15, au & 1, Qb, KVb, AGb, a_sinks);
            STAMP(9);
            if (F.tid == 0) { unsigned sp = 0; while (__hip_atomic_load(gc, __ATOMIC_RELAXED, __HIP_MEMORY_SCOPE_AGENT) < 8u) { __builtin_amdgcn_s_sleep(2); if (++sp > (1u << 22)) break; }
                __builtin_amdgcn_fence(__ATOMIC_ACQUIRE, "agent"); asm volatile("s_waitcnt vmcnt(0)" ::: "memory"); }
            __syncthreads();
            gla_serial(F.lds + RING_OFF, bh, sl, BQb, BKb, BVb, ATTG, DECG, OBU, SSB);
            STAMP(10);
            unsigned* gc2 = gc + 32;
            asm volatile("s_waitcnt vmcnt(0)" ::: "memory");
            __syncthreads();
            if (F.tid == 0) __hip_atomic_fetch_add(gc2, 1u, __ATOMIC_RELAXED, __HIP_MEMORY_SCOPE_AGENT);
            if (serial_first) attn_unit(F.lds + RING_OFF, au >> 5, (au >> 1) & 15, au & 1, Qb, KVb, AGb, a_sinks);
            if (F.tid == 0) { unsigned sp = 0; while (__hip_atomic_load(gc2, __ATOMIC_RELAXED, __HIP_MEMORY_SCOPE_AGENT) < 8u) { __builtin_amdgcn_s_sleep(2); if (++sp > (1u << 22)) break; }
                __builtin_amdgcn_fence(__ATOMIC_ACQUIRE, "agent"); asm volatile("s_waitcnt vmcnt(0)" ::: "memory"); }
            __syncthreads();
            gla_norm_rows(bh, 256 * sl, 256, F.wave, NWAVES, F.lane, OBU, BGb, SSB, b_out_norm_w);
            STAMP(11);
        } else {
            for (int it = F.vcu; it < 1024; it += F.G) gla_pre(F.lds + RING_OFF, it >> 5, it & 31, 1, BQb, BKb, LOGA, ATTG, DECG);
            GRID_BAR();
            for (int it = F.vcu; it < 256; it += F.G) gla_serial(F.lds + RING_OFF, it >> 3, it & 7, BQb, BKb, BVb, ATTG, DECG, OBU, SSB);
            for (int u = blockIdx.x; u < 256; u += F.G) attn_unit(F.lds + RING_OFF, u >> 5, (u >> 1) & 15, u & 1, Qb, KVb, AGb, a_sinks);
            GRID_BAR();
            for (int it = F.vcu; it < 256; it += F.G) gla_norm_rows(it >> 3, 256 * (it & 7), 256, F.wave, NWAVES, F.lane, OBU, BGb, SSB, b_out_norm_w);
        }
        if (BOTH(2)) GRID_BAR();
        STAMP(3);
    }
    STAMP(4);
    if (IN(4)) {
        pg8::Gemm g{AGb, Wabt, M, D, D, 2 * D}; pg8::StaticOrder2 S; S.init(M, D, F.G, (int)blockIdx.x);
        pg8::EpiMerge2 E{MAb, MBb, MERGED};
        pg8::gemm_phase<pg8::EpiMerge2, pg8::StaticOrder2, true, true, true>(F.lds + RING_OFF, g, S, E);
        if (BOTH(4)) GRID_BAR();
        STAMP(5);
    }
    const bool fuse_out = (F.G == 256);
    if (IN(5)) {
        pg8::Gemm g{MERGED, Wot, M, D, D, D}; pg8::StaticOrder S; S.init(M, D, F.G, (int)blockIdx.x);
        if (fuse_out) {
            pg8::EpiOutNorm E{x, args.out, SS2, (unsigned*)(ctl + CW_PANEL), final_norm_w};
            pg8::gemm_phase<pg8::EpiOutNorm, pg8::StaticOrder, false, true>(F.lds + RING_OFF, g, S, E);
        } else {
            pg8::EpiOut E{x, args.out, SS2};
            pg8::gemm_phase<pg8::EpiOut, pg8::StaticOrder, true, true>(F.lds + RING_OFF, g, S, E);
        }
        if (BOTH(5) && !fuse_out) GRID_BAR();
        STAMP(6);
    }
    if (IN(6) && !fuse_out) {
        const int gw = blockIdx.x * NWAVES + F.wave, NGW = F.G * NWAVES;
        for (int m = gw; m < M; m += NGW) {
            const float rstd = 1.0f / sqrtf(SS2[m] * (1.0f / D) + EPS);
            GAS f32x4* o = (GAS f32x4*)(args.out + (size_t)m * D) + F.lane; const GAS f32x4* fw = (const GAS f32x4*)final_norm_w + F.lane;
#pragma unroll
            for (int j = 0; j < 4; ++j) o[64 * j] = o[64 * j] * rstd * fw[64 * j];
        }
    }
#ifdef PROBE_PHASE
    STAMP(7);
    if (blockIdx.x == 0 && F.tid == 0) {
        const unsigned d = (PROBE_PHASE == 20 ? (F.MISC[16 + 8] - F.MISC[16 + 2]) : PROBE_PHASE == 21 ? (F.MISC[16 + 9] - F.MISC[16 + 8]) : PROBE_PHASE == 22 ? (F.MISC[16 + 3] - F.MISC[16 + 9]) : PROBE_PHASE == 23 ? (F.MISC[16 + 10] - F.MISC[16 + 9]) : PROBE_PHASE == 24 ? (F.MISC[16 + 11] - F.MISC[16 + 10]) : PROBE_PHASE == 25 ? (F.MISC[16 + 3] - F.MISC[16 + 11]) : PROBE_PHASE >= 30 ? F.MISC[26 + PROBE_PHASE - 29] : (F.MISC[16 + PROBE_PHASE + 1] - F.MISC[16 + PROBE_PHASE])) * 4u; const unsigned t0 = (unsigned)__builtin_amdgcn_s_memrealtime();
        while ((unsigned)__builtin_amdgcn_s_memrealtime() - t0 < d) __builtin_amdgcn_s_sleep(8);
    }
#endif
#undef IN
#undef BOTH
}

#ifndef MK_N_LAUNCHES
#define MK_N_LAUNCHES 1
#endif
#ifndef MK_USE_CG
#define MK_USE_CG 0
#endif
extern "C" void kernel_launch(void* const* d_in, const int* in_sizes, int n_in, void* d_out, int out_size, void* d_ws, size_t ws_size, hipStream_t stream) {
    static int grid = 0;
    if (grid == 0) {
        if (n_in != 12 || in_sizes[0] != M * D || out_size != M * D || ws_size < WS_END) { fprintf(stderr, "kernel_launch: unexpected shapes (n_in %d, in0 %d, out %d, ws %zu)\n", n_in, n_in > 0 ? in_sizes[0] : -1, out_size, ws_size); grid = -1; return; }
        int dev = 0, cus = 0, per_cu = 0;
        if (hipGetDevice(&dev) != hipSuccess || hipDeviceGetAttribute(&cus, hipDeviceAttributeMultiprocessorCount, dev) != hipSuccess) { grid = -1; return; }
        if (hipFuncSetAttribute((const void*)hybrid_fwd, hipFuncAttributeMaxDynamicSharedMemorySize, LDS_BYTES) != hipSuccess) { fprintf(stderr, "kernel_launch: hipFuncSetAttribute failed\n"); grid = -1; return; }
        if (hipOccupancyMaxActiveBlocksPerMultiprocessor(&per_cu, (const void*)hybrid_fwd, NWAVES * 64, LDS_BYTES) != hipSuccess || per_cu < 1) { fprintf(stderr, "kernel_launch: occupancy query says %d\n", per_cu); per_cu = 1; }
        (void)hipGetLastError();
        grid = cus;
    }
    if (grid < 0) return;
    if (hipMemsetAsync((char*)d_ws + WS_CTL, 0, CTL_ZERO_BYTES, stream) != hipSuccess) { fprintf(stderr, "kernel_launch: memset failed\n"); return; }
    Args a{};
    for (int i = 0; i < 12; ++i) a.in[i] = (const float*)d_in[i];
    a.out = (float*)d_out; a.ws = (unsigned char*)d_ws; a.use_cg = MK_USE_CG; a.dummy = 0;
    if (MK_N_LAUNCHES == 1) {
        a.ph_lo = 0; a.ph_hi = N_PHASES;
        void* kargs[] = {&a};
        hipError_t e = hipLaunchCooperativeKernel((const void*)hybrid_fwd, dim3(grid), dim3(NWAVES * 64), kargs, LDS_BYTES, stream);
        if (e != hipSuccess) fprintf(stderr, "kernel_launch: cooperative launch failed: %s (grid %d)\n", hipGetErrorString(e), grid);
    } else {
        for (int li = 0; li < N_PHASES; ++li) {
            a.ph_lo = li; a.ph_hi = li + 1;
#ifdef PROBE_DUP
            if (li == PROBE_DUP) { a.dummy = (li == 2); hipLaunchKernelGGL(hybrid_fwd, dim3(grid), dim3(NWAVES * 64), LDS_BYTES, stream, a); a.dummy = 0; }
#endif
            hipLaunchKernelGGL(hybrid_fwd, dim3(grid), dim3(NWAVES * 64), LDS_BYTES, stream, a);
        }
    }
}
```

```cpp
#include <hip/hip_runtime.h>
#include <hip/hip_cooperative_groups.h>
#include <cstdio>
#include <cstdint>
#include <cmath>
namespace cg = cooperative_groups;
constexpr int NWAVES = 8;
constexpr int BATCH = 8, T = 2048, D = 1024, M = BATCH * T;
constexpr int N1 = 7936;
constexpr int INW = 7440;
constexpr float EPS = 1e-5f;
constexpr size_t MiB = 1u << 20;
constexpr size_t WS_CTL = 0, CTL_ZERO_BYTES = 128 * 1024;
constexpr size_t WS_SS2 = 256 * 1024;
constexpr size_t WS_SSB = 512 * 1024;
constexpr size_t WS_W1 = 1 * MiB;
constexpr size_t WS_WA = WS_W1 + (size_t)N1 * 1024 * 2, WS_WB = WS_WA + 2 * MiB, WS_WO = WS_WB + 2 * MiB;
constexpr size_t WS_XN = 23 * MiB;
constexpr size_t WS_Q = 55 * MiB;
constexpr size_t WS_KV = 87 * MiB;
constexpr size_t WS_BQ = 95 * MiB, WS_BK = 111 * MiB;
constexpr size_t WS_BV = 127 * MiB;
constexpr size_t WS_AG = 159 * MiB;
constexpr size_t WS_BG = 191 * MiB;
constexpr size_t WS_LOGA = 223 * MiB;
constexpr size_t WS_END = 255 * MiB;
constexpr size_t WS_YA = WS_Q;
static_assert(WS_WO + 2 * MiB <= WS_XN && WS_YA + 64 * MiB <= WS_BV, "ws map");
constexpr int CW_BAR = 4096, CW_PANEL = 8192, CW_GLA = 12288;
namespace pg8 {
#define PG8_LAS __attribute__((address_space(3)))
typedef unsigned short bf16_t;
typedef short bf16x8 __attribute__((ext_vector_type(8)));
typedef float f32x4 __attribute__((ext_vector_type(4)));
typedef unsigned u32x4 __attribute__((ext_vector_type(4)));
constexpr int BM = 256, BK = 64, HALF = 128, HTB = HALF * BK * 2  , STAGE_BYTES = 8 * HTB, NXCD = 8, WGM = 2;

__host__ __device__ __forceinline__ int lds_byte(int r, int c) { const int st = (r >> 4) * 2 + (c >> 5), rr = r & 15, cc = c & 31, ob = rr * 64 + cc * 2; return st * 1024 + (ob ^ (((ob >> 9) & 1) << 5)); }
__host__ __device__ __forceinline__ void stage_rc(int b, int& R, int& C) { const int st = b / 1024, sb = b % 1024, swz = sb ^ (((sb >> 9) & 1) << 5); R = (st >> 1) * 16 + swz / 64; C = (st & 1) * 32 + (swz % 64) / 2; }
__host__ __device__ __forceinline__ int perm32(int rho) { const int n = rho >> 4, i = rho & 15; return 8 * (i >> 2) + 4 * n + (i & 3); }

struct Unit { int pm, pn, seg; };
struct Gemm { const bf16_t* A; const bf16_t* Bt; int M, N, K, ld; };

struct StaticOrder {
    int nM, nN, nwg, G, c;
    __host__ __device__ void init(int M, int N, int G_, int c_) { nM = M / BM; nN = N / BM; nwg = nM * nN; G = G_; c = c_; }
    __host__ __device__ bool next(int i, Unit& u) const {
        const long L = (long)i * G + c; if (L >= nwg) return false;
        int wgid = (int)L; { const int q = nwg / NXCD, r = nwg % NXCD, xcd = wgid % NXCD, off = wgid / NXCD; wgid = (xcd < r ? xcd * (q + 1) : r * (q + 1) + (xcd - r) * q) + off; }
        const int nig = WGM * nN, gid = wgid / nig, fm = gid * WGM, gsz = (nM - fm) < WGM ? (nM - fm) : WGM;
        u.pm = fm + ((wgid % nig) % gsz); u.pn = (wgid % nig) / gsz; u.seg = 0; return true;
    }
    __device__ __forceinline__ void a_ready(const Unit&) const {}
    __device__ __forceinline__ void done(const Unit&) const {}
};


struct StaticOrder2 {
    StaticOrder in;
    __host__ __device__ void init(int M, int N, int G_, int c_) { in.init(M, N, G_, c_); }
    __host__ __device__ bool next(int i, Unit& u) const { if (!in.next(i >> 1, u)) return false; u.seg = i & 1; return true; }
    __device__ __forceinline__ void a_ready(const Unit&) const {}
    __device__ __forceinline__ void done(const Unit&) const {}
};

__device__ __forceinline__ unsigned cvt_pk_bf16(float lo, float hi) { unsigned r; asm volatile("v_cvt_pk_bf16_f32 %0, %1, %2" : "=v"(r) : "v"(lo), "v"(hi)); return r; }
__device__ __forceinline__ float bf_lo(unsigned w) { return __uint_as_float(w << 16); }
__device__ __forceinline__ float bf_hi(unsigned w) { return __uint_as_float(w & 0xffff0000u); }
__device__ __forceinline__ void store8bf(bf16_t* p, const f32x4& v0, const f32x4& v1) {
    u32x4 w; w.x = cvt_pk_bf16(v0[0], v0[1]); w.y = cvt_pk_bf16(v0[2], v0[3]); w.z = cvt_pk_bf16(v1[0], v1[1]); w.w = cvt_pk_bf16(v1[2], v1[3]); *(u32x4*)p = w;
}
__device__ __forceinline__ void load8bf(const bf16_t* p, f32x4& v0, f32x4& v1) {
    const u32x4 w = *(const u32x4*)p;
    v0 = (f32x4){bf_lo(w.x), bf_hi(w.x), bf_lo(w.y), bf_hi(w.y)}; v1 = (f32x4){bf_lo(w.z), bf_hi(w.z), bf_lo(w.w), bf_hi(w.w)};
}
__device__ __forceinline__ void sincos_cw(float a, float& s, float& c) {
    const float kf = rintf(a * 0.63661977236758134f);
    float r = fmaf(-kf, 1.5703125f, a); r = fmaf(-kf, 4.837512969970703125e-4f, r); r = fmaf(-kf, 7.54978995489188216e-8f, r);
    const float r2 = r * r;
    float sp = fmaf(r2, 2.7557319e-6f, -1.9841270e-4f); sp = fmaf(sp, r2, 8.3333333e-3f); sp = fmaf(sp, r2, -1.6666667e-1f); sp = fmaf(sp * r2, r, r);
    float cp = fmaf(r2, -2.7557319e-7f, 2.4801587e-5f); cp = fmaf(cp, r2, -1.3888889e-3f); cp = fmaf(cp, r2, 4.1666667e-2f); cp = fmaf(cp, r2, -0.5f); cp = fmaf(cp, r2, 1.0f);
    const int q = ((int)kf) & 3;
    const float s1 = (q & 1) ? cp : sp, c1 = (q & 1) ? sp : cp;
    s = (q & 2) ? -s1 : s1; c = ((q + 1) & 2) ? -c1 : c1;
}
constexpr float QSCALE = 0.125f * 1.4426950408889634f;
struct EpiP1 {
    static constexpr bool PERM = true, AFTER_DRAIN = false;
    unsigned char* ws; unsigned char* outb; const int* pos; const float* gbias;
    __device__ __forceinline__ void operator()(const f32x4 (&acc)[2][2][4][2], const Unit& u, int wr, int wc, int fr, int fq) const {
        const int pn = u.pn; const int row0 = u.pm * BM + wr * 64 + fr; const int cl = wc * 32 + 8 * fq;
        if (pn <= 4) {
            bf16_t* base = (bf16_t*)(ws + (pn < 4 ? WS_Q + (size_t)pn * 512 : WS_KV)); const int ld = pn < 4 ? 1024 : 256; const float sc = pn < 4 ? QSCALE : 1.0f;
            float invf[4];
#pragma unroll
            for (int i = 0; i < 4; ++i) invf[i] = exp2f(-(float)(16 * (wc & 1) + 4 * fq + i) * (13.287712379549449f / 32.0f));
#pragma unroll
            for (int ai = 0; ai < 2; ++ai)
#pragma unroll
                for (int m = 0; m < 4; ++m) {
                    const int row = row0 + ai * HALF + m * 16; const float pf = (float)pos[row];
                    f32x4 cs, sn;
#pragma unroll
                    for (int i = 0; i < 4; ++i) { float s_, c_; sincos_cw(pf * invf[i], s_, c_); cs[i] = c_ * sc; sn[i] = s_ * sc; }
#pragma unroll
                    for (int bj = 0; bj < 2; ++bj) {
                        const f32x4 x1 = acc[ai][bj][m][0], x2 = acc[ai][bj][m][1];
                        f32x4 o1, o2;
                        if (pn == 4 && bj == 1) { o1 = x1; o2 = x2; }
                        else { o1 = x1 * cs - x2 * sn; o2 = x2 * cs + x1 * sn; }
                        store8bf(base + (size_t)row * ld + bj * HALF + cl, o1, o2);
                    }
                }
        } else if (pn >= 29) {
            const int cgk = (pn - 29) * 256 + cl;
#pragma unroll
            for (int bj = 0; bj < 2; ++bj) {
                const f32x4 b0 = *(const f32x4*)(gbias + cgk + bj * HALF), b1 = *(const f32x4*)(gbias + cgk + bj * HALF + 4);
#pragma unroll
                for (int ai = 0; ai < 2; ++ai)
#pragma unroll
                    for (int m = 0; m < 4; ++m) {
                        const int row = row0 + ai * HALF + m * 16;
                        f32x4 g0 = acc[ai][bj][m][0] + b0, g1 = acc[ai][bj][m][1] + b1;
#pragma unroll
                        for (int i = 0; i < 4; ++i) {
                            g0[i] = (fminf(g0[i], 0.f) - __logf(1.0f + __expf(-fabsf(g0[i])))) * 0.0625f;
                            g1[i] = (fminf(g1[i], 0.f) - __logf(1.0f + __expf(-fabsf(g1[i])))) * 0.0625f;
                        }
                        float* p = (float*)(ws + WS_LOGA) + (size_t)row * 512 + cgk + bj * HALF;
                        *(f32x4*)p = g0; *(f32x4*)(p + 4) = g1;
                    }
            }
        } else {
            const size_t off = pn < 9 ? WS_AG + (size_t)(pn - 5) * 512 : pn < 11 ? WS_BQ + (size_t)(pn - 9) * 512 : pn < 13 ? WS_BK + (size_t)(pn - 11) * 512 : pn < 17 ? WS_BV + (size_t)(pn - 13) * 512
                             : pn < 21 ? WS_AG + 2048 + (size_t)(pn - 17) * 512 : pn < 25 ? (size_t)(pn - 21) * 512 : (size_t)M * 2048 + (size_t)(pn - 25) * 512;
            const int ld = (pn >= 9 && pn < 13) ? 512 : (pn < 9 || (pn >= 17 && pn < 21)) ? 2048 : 1024; const int act = pn < 9 ? 1 : pn < 17 ? 0 : pn < 21 ? 1 : 2;
            bf16_t* base = (bf16_t*)((pn < 21 ? ws : outb) + off) + cl;
#pragma unroll
            for (int ai = 0; ai < 2; ++ai)
#pragma unroll
                for (int m = 0; m < 4; ++m) {
                    const int row = row0 + ai * HALF + m * 16;
#pragma unroll
                    for (int bj = 0; bj < 2; ++bj) {
                        f32x4 v0 = acc[ai][bj][m][0], v1 = acc[ai][bj][m][1];
                        if (act) {
#pragma unroll
                            for (int i = 0; i < 4; ++i) {
                                const float s0 = __builtin_amdgcn_rcpf(1.0f + __expf(-v0[i])), s1 = __builtin_amdgcn_rcpf(1.0f + __expf(-v1[i]));
                                v0[i] = act == 1 ? v0[i] * s0 : s0; v1[i] = act == 1 ? v1[i] * s1 : s1;
                            }
                        }
                        store8bf(base + (size_t)row * ld + bj * HALF, v0, v1);
                    }
                }
        }
    }
};
struct EpiScaleF32 {
    static constexpr bool PERM = true, AFTER_DRAIN = false;
    const bf16_t* G; float* Y;
    __device__ __forceinline__ void operator()(const f32x4 (&acc)[2][2][4][2], const Unit& u, int wr, int wc, int fr, int fq) const {
        const int row0 = u.pm * BM + wr * 64 + fr; const int col0 = u.pn * BM + wc * 32 + 8 * fq;
#pragma unroll
        for (int ai = 0; ai < 2; ++ai)
#pragma unroll
            for (int m = 0; m < 4; ++m) {
                const size_t ro = (size_t)(row0 + ai * HALF + m * 16) * 1024 + col0;
#pragma unroll
                for (int bj = 0; bj < 2; ++bj) {
                    f32x4 g0, g1; load8bf(G + ro + bj * HALF, g0, g1);
                    *(f32x4*)(Y + ro + bj * HALF) = acc[ai][bj][m][0] * g0; *(f32x4*)(Y + ro + bj * HALF + 4) = acc[ai][bj][m][1] * g1;
                }
            }
    }
};
struct EpiMerge {
    static constexpr bool PERM = true, AFTER_DRAIN = false;
    const bf16_t* G; const float* Y; bf16_t* O;
    __device__ __forceinline__ void operator()(const f32x4 (&acc)[2][2][4][2], const Unit& u, int wr, int wc, int fr, int fq) const {
        const int row0 = u.pm * BM + wr * 64 + fr; const int col0 = u.pn * BM + wc * 32 + 8 * fq;
#pragma unroll
        for (int ai = 0; ai < 2; ++ai)
#pragma unroll
            for (int m = 0; m < 4; ++m) {
                const size_t ro = (size_t)(row0 + ai * HALF + m * 16) * 1024 + col0;
#pragma unroll
                for (int bj = 0; bj < 2; ++bj) {
                    f32x4 g0, g1; load8bf(G + ro + bj * HALF, g0, g1);
                    const f32x4 y0 = *(const f32x4*)(Y + ro + bj * HALF), y1 = *(const f32x4*)(Y + ro + bj * HALF + 4);
                    store8bf(O + ro + bj * HALF, y0 + acc[ai][bj][m][0] * g0, y1 + acc[ai][bj][m][1] * g1);
                }
            }
    }
};
struct EpiOut {
    static constexpr bool PERM = true, AFTER_DRAIN = false;
    const float* X; float* O; float* SS;
    __device__ __forceinline__ void operator()(const f32x4 (&acc)[2][2][4][2], const Unit& u, int wr, int wc, int fr, int fq) const {
        const int row0 = u.pm * BM + wr * 64 + fr; const int col0 = u.pn * BM + wc * 32 + 8 * fq;
#pragma unroll
        for (int ai = 0; ai < 2; ++ai)
#pragma unroll
            for (int m = 0; m < 4; ++m) {
                const int row = row0 + ai * HALF + m * 16; const size_t ro = (size_t)row * 1024 + col0; float ss = 0.f;
#pragma unroll
                for (int bj = 0; bj < 2; ++bj) {
                    const f32x4 x0 = *(const f32x4*)(X + ro + bj * HALF), x1 = *(const f32x4*)(X + ro + bj * HALF + 4);
                    const f32x4 o0 = x0 + acc[ai][bj][m][0], o1 = x1 + acc[ai][bj][m][1];
                    *(f32x4*)(O + ro + bj * HALF) = o0; *(f32x4*)(O + ro + bj * HALF + 4) = o1;
                    ss += (o0[0] * o0[0] + o0[1] * o0[1]) + (o0[2] * o0[2] + o0[3] * o0[3]) + (o1[0] * o1[0] + o1[1] * o1[1]) + (o1[2] * o1[2] + o1[3] * o1[3]);
                }
                ss += __shfl_xor(ss, 16); ss += __shfl_xor(ss, 32);
                if (fq == 0) atomicAdd(SS + row, ss);
            }
    }
};

struct EpiOutNorm {
    static constexpr bool PERM = true, AFTER_DRAIN = true;
    const float* X; float* O; float* SS; unsigned* cnt; const float* fw;
    __device__ __forceinline__ void fused(f32x4 (&acc)[2][2][4][2], const Unit& u, int wr, int wc, int fr, int fq, PG8_LAS unsigned char* lds, int wid, int lane) const {
        const int row0 = u.pm * BM + wr * 64 + fr; const int col0 = u.pn * BM + wc * 32 + 8 * fq;
#pragma unroll
        for (int ai = 0; ai < 2; ++ai)
#pragma unroll
            for (int m = 0; m < 4; ++m) {
                const int row = row0 + ai * HALF + m * 16; const size_t ro = (size_t)row * 1024 + col0; float ss = 0.f;
#pragma unroll
                for (int bj = 0; bj < 2; ++bj) {
                    const f32x4 x0 = *(const f32x4*)(X + ro + bj * HALF), x1 = *(const f32x4*)(X + ro + bj * HALF + 4);
                    const f32x4 o0 = x0 + acc[ai][bj][m][0], o1 = x1 + acc[ai][bj][m][1];
                    acc[ai][bj][m][0] = o0; acc[ai][bj][m][1] = o1;
                    ss += (o0[0] * o0[0] + o0[1] * o0[1]) + (o0[2] * o0[2] + o0[3] * o0[3]) + (o1[0] * o1[0] + o1[1] * o1[1]) + (o1[2] * o1[2] + o1[3] * o1[3]);
                }
                ss += __shfl_xor(ss, 16); ss += __shfl_xor(ss, 32);
                if (fq == 0) __hip_atomic_fetch_add(SS + row, ss, __ATOMIC_RELAXED, __HIP_MEMORY_SCOPE_AGENT);
            }
        asm volatile("s_waitcnt vmcnt(0)" ::: "memory");
        __syncthreads();
        if (threadIdx.x == 0) {
            unsigned* c = cnt + 64 * u.pm;
            __hip_atomic_fetch_add(c, 1u, __ATOMIC_RELAXED, __HIP_MEMORY_SCOPE_AGENT);
            unsigned sp = 0;
            while (__hip_atomic_load(c, __ATOMIC_RELAXED, __HIP_MEMORY_SCOPE_AGENT) < 4u) { __builtin_amdgcn_s_sleep(2); if (++sp > (1u << 22)) break; }
        }
        __syncthreads();
        f32x4 w0[2], w1[2];
#pragma unroll
        for (int bj = 0; bj < 2; ++bj) { w0[bj] = *(const f32x4*)(fw + col0 + bj * HALF); w1[bj] = *(const f32x4*)(fw + col0 + bj * HALF + 4); }
#pragma unroll
        for (int ai = 0; ai < 2; ++ai)
#pragma unroll
            for (int m = 0; m < 4; ++m) {
                const int row = row0 + ai * HALF + m * 16; const size_t ro = (size_t)row * 1024 + col0;
                const float rstd = 1.0f / sqrtf(__hip_atomic_load(SS + row, __ATOMIC_RELAXED, __HIP_MEMORY_SCOPE_AGENT) * (1.0f / 1024.0f) + 1e-5f);
#pragma unroll
                for (int bj = 0; bj < 2; ++bj) {
                    *(f32x4*)(O + ro + bj * HALF) = acc[ai][bj][m][0] * rstd * w0[bj]; *(f32x4*)(O + ro + bj * HALF + 4) = acc[ai][bj][m][1] * rstd * w1[bj];
                }
            }
    }
};

struct EpiMerge2 {
    static constexpr bool PERM = true, AFTER_DRAIN = false;
    const bf16_t* GA; const bf16_t* GB; bf16_t* O;
    __device__ __forceinline__ void mid(f32x4 (&acc)[2][2][4][2], const Unit& u, int wr, int wc, int fr, int fq) const {
        const int row0 = u.pm * BM + wr * 64 + fr; const int col0 = u.pn * BM + wc * 32 + 8 * fq;
#pragma unroll
        for (int ai = 0; ai < 2; ++ai)
#pragma unroll
            for (int m = 0; m < 4; ++m) {
                const size_t ro = (size_t)(row0 + ai * HALF + m * 16) * 1024 + col0;
#pragma unroll
                for (int bj = 0; bj < 2; ++bj) {
                    f32x4 a0, a1, b0, b1; load8bf(GA + ro + bj * HALF, a0, a1); load8bf(GB + ro + bj * HALF, b0, b1);
#pragma unroll
                    for (int i = 0; i < 4; ++i) { acc[ai][bj][m][0][i] *= a0[i] * __builtin_amdgcn_rcpf(fmaxf(b0[i], 1e-30f)); acc[ai][bj][m][1][i] *= a1[i] * __builtin_amdgcn_rcpf(fmaxf(b1[i], 1e-30f)); }
                }
                asm volatile("" : "+v"(acc[ai][0][m][0]), "+v"(acc[ai][0][m][1]), "+v"(acc[ai][1][m][0]), "+v"(acc[ai][1][m][1]));
                if (m & 1) asm volatile("" ::: "memory");
            }
    }
    __device__ __forceinline__ void operator()(const f32x4 (&acc)[2][2][4][2], const Unit& u, int wr, int wc, int fr, int fq) const {
        if (u.seg == 0) { mid(const_cast<f32x4 (&)[2][2][4][2]>(acc), u, wr, wc, fr, fq); return; }
        const int row0 = u.pm * BM + wr * 64 + fr; const int col0 = u.pn * BM + wc * 32 + 8 * fq;
#pragma unroll
        for (int ai = 0; ai < 2; ++ai)
#pragma unroll
            for (int m = 0; m < 4; ++m) {
                const size_t ro = (size_t)(row0 + ai * HALF + m * 16) * 1024 + col0;
#pragma unroll
                for (int bj = 0; bj < 2; ++bj) {
                    f32x4 g0, g1; load8bf(GB + ro + bj * HALF, g0, g1);
                    store8bf(O + ro + bj * HALF, acc[ai][bj][m][0] * g0, acc[ai][bj][m][1] * g1);
                }
            }
    }
};
template <class Epi, class Sched, bool ALIGN_EPI = false, bool SP2 = false, bool MID = false>
__device__ __forceinline__ void gemm_phase(PG8_LAS unsigned char* lds, const Gemm g, const Sched& S, const Epi& E) {
    const int tid = threadIdx.x, wid = __builtin_amdgcn_readfirstlane(tid >> 6), lane = tid & 63, wr = wid >> 2, wc = wid & 3, fr = lane & 15, fq = lane >> 4;
    const int K = g.ld, nt = g.K / BK;
    const size_t segb = (size_t)g.K * 2;
    unsigned voffA[2], voffB[2];
#pragma unroll
    for (int i = 0; i < 2; ++i) { int R, C; stage_rc(tid * 16 + i * 8192, R, C); const int Rb = Epi::PERM ? ((R & ~31) + perm32(R & 31)) : R;
        voffA[i] = (unsigned)(R * K + C) * 2u; voffB[i] = (unsigned)(Rb * K + C) * 2u; }
    const size_t kstep = (size_t)(BK * 2);
    const size_t hstep = (size_t)HALF * K * 2;
    const size_t tstep = 2 * hstep;
    const unsigned ldsw = (unsigned)wid * 1024u;
    const int aoff = lds_byte(wr * 64 + fr, fq * 8), boff = lds_byte(wc * 32 + fr, fq * 8);
#define PG8_SA(b, h) (((b) * 2 + (h)) * HTB)
#define PG8_SB(b, h) ((4 + (b) * 2 + (h)) * HTB)
#define PG8_STAGE(bufoff, gbase, voff) do { _Pragma("unroll") for (int _i = 0; _i < 2; ++_i) \
        __builtin_amdgcn_global_load_lds((const unsigned*)((const char*)(gbase) + (voff)[_i]), (PG8_LAS unsigned*)(lds + (bufoff) + ldsw + _i * 8192), 16, 0, 0); } while (0)
#define PG8_LDA(dst, b, h) do { _Pragma("unroll") for (int m = 0; m < 4; ++m) _Pragma("unroll") for (int k = 0; k < 2; ++k) dst[m][k] = *(const PG8_LAS bf16x8*)(lds + PG8_SA(b, h) + aoff + m * 2048 + k * 1024); } while (0)
#define PG8_LDB(dst, b, h) do { _Pragma("unroll") for (int n = 0; n < 2; ++n) _Pragma("unroll") for (int k = 0; k < 2; ++k) dst[n][k] = *(const PG8_LAS bf16x8*)(lds + PG8_SB(b, h) + boff + n * 2048 + k * 1024); } while (0)
#define PG8_MMA(ai, bj, At, Bt) do { __builtin_amdgcn_s_setprio(1); _Pragma("unroll") for (int m = 0; m < 4; ++m) _Pragma("unroll") for (int n = 0; n < 2; ++n) _Pragma("unroll") for (int k = 0; k < 2; ++k) \
        acc[ai][bj][m][n] = __builtin_amdgcn_mfma_f32_16x16x32_bf16(Bt[n][k], At[m][k], acc[ai][bj][m][n], 0, 0, 0); __builtin_amdgcn_s_setprio(0); } while (0)
#define PG8_WAIT_V(n) asm volatile("s_waitcnt vmcnt(" #n ")" ::: "memory")
#define PG8_WAIT_L(n) asm volatile("s_waitcnt lgkmcnt(" #n ")" ::: "memory")
#define PG8_BAR __builtin_amdgcn_s_barrier()
#define PG8_SCHED __builtin_amdgcn_sched_barrier(0)
    Unit cur, nxt; int ui = 0;
    if (!S.next(0, cur)) return;
    f32x4 acc[2][2][4][2];
#pragma unroll
    for (int a = 0; a < 2; ++a)
#pragma unroll
        for (int b = 0; b < 2; ++b)
#pragma unroll
            for (int m = 0; m < 4; ++m)
#pragma unroll
                for (int n = 0; n < 2; ++n) acc[a][b][m][n] = (f32x4){0.f, 0.f, 0.f, 0.f};
    bf16x8 At[4][2], B0[2][2], B1[2][2];
    const char* cA = (const char*)g.A + (size_t)cur.pm * tstep + cur.seg * segb; const char* cB = (const char*)g.Bt + (size_t)cur.pn * tstep + cur.seg * segb;
    S.a_ready(cur);
    if constexpr (SP2) {
        PG8_STAGE(PG8_SB(0, 0), cB, voffB); PG8_STAGE(PG8_SB(0, 1), cB + hstep, voffB); PG8_STAGE(PG8_SA(0, 0), cA, voffA); PG8_STAGE(PG8_SA(0, 1), cA + hstep, voffA);
        if (wr == 1) PG8_BAR;
        PG8_WAIT_V(2); PG8_BAR;
        PG8_STAGE(PG8_SB(1, 0), cB + kstep, voffB); PG8_STAGE(PG8_SA(1, 0), cA + kstep, voffA); PG8_STAGE(PG8_SB(1, 1), cB + hstep + kstep, voffB);
        PG8_WAIT_V(6); PG8_BAR;
    } else {
        PG8_STAGE(PG8_SB(0, 0), cB, voffB); PG8_STAGE(PG8_SA(0, 0), cA, voffA); PG8_STAGE(PG8_SB(0, 1), cB + hstep, voffB); PG8_STAGE(PG8_SA(0, 1), cA + hstep, voffA);
        if (wr == 1) PG8_BAR;
        PG8_WAIT_V(4); PG8_BAR;
        PG8_STAGE(PG8_SB(1, 0), cB + kstep, voffB); PG8_STAGE(PG8_SA(1, 0), cA + kstep, voffA); PG8_STAGE(PG8_SB(1, 1), cB + hstep + kstep, voffB);
        PG8_WAIT_V(6); PG8_BAR;
    }
    for (;;) {
        const bool has_next = S.next(ui + 1, nxt);
        const char* nA = has_next ? (const char*)g.A + (size_t)nxt.pm * tstep + nxt.seg * segb : cA; const char* nB = has_next ? (const char*)g.Bt + (size_t)nxt.pn * tstep + nxt.seg * segb : cB;
        for (int t = 0; t < nt; t += 2) {
            const bool last = (t == nt - 2);
            const char* a1 = cA + (size_t)(t + 1) * kstep;
            const char* a2 = last ? nA : cA + (size_t)(t + 2) * kstep; const char* b2 = last ? nB : cB + (size_t)(t + 2) * kstep;
            const char* a3 = a2 + kstep; const char* b3 = b2 + kstep;
            if (last && has_next) S.a_ready(nxt);
            if constexpr (SP2) {
            PG8_LDB(B0, 0, 0); PG8_LDB(B1, 0, 1); PG8_SCHED; PG8_LDA(At, 0, 0); PG8_STAGE(PG8_SA(1, 1), a1 + hstep, voffA);
            PG8_WAIT_V(8); PG8_WAIT_L(0); PG8_BAR; PG8_MMA(0, 0, At, B0); PG8_MMA(0, 1, At, B1); PG8_BAR; PG8_SCHED;
            PG8_LDA(At, 0, 1); PG8_STAGE(PG8_SB(0, 0), b2, voffB); PG8_STAGE(PG8_SB(0, 1), b2 + hstep, voffB); PG8_STAGE(PG8_SA(0, 0), a2, voffA);
            PG8_WAIT_V(8); PG8_WAIT_L(0); PG8_BAR; PG8_MMA(1, 0, At, B0); PG8_MMA(1, 1, At, B1); PG8_BAR; PG8_SCHED;
            PG8_LDB(B0, 1, 0); PG8_LDB(B1, 1, 1); PG8_SCHED; PG8_LDA(At, 1, 0); PG8_STAGE(PG8_SA(0, 1), a2 + hstep, voffA);
            PG8_WAIT_V(8); PG8_WAIT_L(0); PG8_BAR; PG8_MMA(0, 0, At, B0); PG8_MMA(0, 1, At, B1); PG8_BAR; PG8_SCHED;
            PG8_LDA(At, 1, 1); PG8_STAGE(PG8_SB(1, 0), b3, voffB); PG8_STAGE(PG8_SB(1, 1), b3 + hstep, voffB); PG8_STAGE(PG8_SA(1, 0), a3, voffA);
            PG8_WAIT_V(8); PG8_WAIT_L(0); PG8_BAR; PG8_MMA(1, 0, At, B0); PG8_MMA(1, 1, At, B1); PG8_BAR; PG8_SCHED;
            } else {
            PG8_LDB(B0, 0, 0); PG8_SCHED; PG8_LDA(At, 0, 0); PG8_STAGE(PG8_SA(1, 1), a1 + hstep, voffA);
            PG8_WAIT_L(8); PG8_BAR; PG8_WAIT_L(0); PG8_MMA(0, 0, At, B0); PG8_BAR; PG8_SCHED;
            PG8_LDB(B1, 0, 1); PG8_STAGE(PG8_SB(0, 0), b2, voffB);
            PG8_BAR; PG8_WAIT_L(0); PG8_MMA(0, 1, At, B1); PG8_BAR;
            PG8_LDA(At, 0, 1); PG8_STAGE(PG8_SA(0, 0), a2, voffA);
            PG8_BAR; PG8_WAIT_L(0); PG8_MMA(1, 0, At, B0); PG8_BAR; PG8_SCHED;
            PG8_STAGE(PG8_SB(0, 1), b2 + hstep, voffB);
            PG8_WAIT_V(6); PG8_BAR; PG8_MMA(1, 1, At, B1); PG8_BAR;
            PG8_LDB(B0, 1, 0); PG8_SCHED; PG8_LDA(At, 1, 0); PG8_STAGE(PG8_SA(0, 1), a2 + hstep, voffA);
            PG8_WAIT_L(8); PG8_BAR; PG8_WAIT_L(0); PG8_MMA(0, 0, At, B0); PG8_BAR; PG8_SCHED;
            PG8_LDB(B1, 1, 1); PG8_STAGE(PG8_SB(1, 0), b3, voffB);
            PG8_BAR; PG8_WAIT_L(0); PG8_MMA(0, 1, At, B1); PG8_BAR;
            PG8_LDA(At, 1, 1); PG8_STAGE(PG8_SA(1, 0), a3, voffA);
            PG8_BAR; PG8_WAIT_L(0); PG8_MMA(1, 0, At, B0); PG8_BAR; PG8_SCHED;
            PG8_STAGE(PG8_SB(1, 1), b3 + hstep, voffB);
            PG8_WAIT_V(6); PG8_BAR; PG8_MMA(1, 1, At, B1); PG8_BAR;
            }
        }
        if constexpr (ALIGN_EPI) { if (wr == 0) PG8_BAR; }
        if constexpr (!Epi::AFTER_DRAIN) { E(acc, cur, wr, wc, fr, fq); S.done(cur); }
        if (!has_next) break;
        if (!(MID && cur.seg == 0))
#pragma unroll
        for (int a = 0; a < 2; ++a)
#pragma unroll
            for (int b = 0; b < 2; ++b)
#pragma unroll
                for (int m = 0; m < 4; ++m)
#pragma unroll
                    for (int n = 0; n < 2; ++n) acc[a][b][m][n] = (f32x4){0.f, 0.f, 0.f, 0.f};
        cur = nxt; cA = nA; cB = nB; ++ui;
        if constexpr (ALIGN_EPI) { if (wr == 1) PG8_BAR; }
    }
    PG8_WAIT_V(0);
    if constexpr (!ALIGN_EPI) { if (wr == 0) PG8_BAR; }
    PG8_BAR;
    if constexpr (Epi::AFTER_DRAIN) { E.fused(acc, cur, wr, wc, fr, fq, lds, wid, lane); S.done(cur); }
#undef PG8_SA
#undef PG8_SB
#undef PG8_STAGE
#undef PG8_LDA
#undef PG8_LDB
#undef PG8_MMA
#undef PG8_WAIT_V
#undef PG8_WAIT_L
#undef PG8_BAR
#undef PG8_SCHED
}
}
#define GAS __attribute__((address_space(1)))
#define LAS __attribute__((address_space(3)))
typedef unsigned short bf16;
typedef unsigned v4u __attribute__((ext_vector_type(4)));
typedef float f32x4 __attribute__((ext_vector_type(4)));
typedef short bf16x8 __attribute__((ext_vector_type(8)));
typedef GAS unsigned gu32;
typedef GAS unsigned long long gu64;
#define RLX_AGENT __ATOMIC_RELAXED, __HIP_MEMORY_SCOPE_AGENT
#define LDS_WAIT() asm volatile("s_waitcnt lgkmcnt(0)" ::: "memory")
#define VM_WAIT() asm volatile("s_waitcnt vmcnt(0)" ::: "memory")
__device__ __forceinline__ unsigned long long rt() { return __builtin_amdgcn_s_memrealtime(); }
__device__ __forceinline__ unsigned f2bf(float f) { unsigned u = __builtin_bit_cast(unsigned, f); return (u + 0x7fffu + ((u >> 16) & 1u)) >> 16; }
__device__ __forceinline__ unsigned pk2(float lo, float hi) { return f2bf(lo) | (f2bf(hi) << 16); }

#define XB_TMO      128
#define XB_XCNT(j)  (256  + 64 * (j))
#define XB_XSUB(j)  (1280 + 64 * (j))
#define XB_XGEN(j)  (2304 + 64 * (j))
#define XB_TOP      3328
#define XB_TOPGEN   3392
#define XCD_BAR_WORDS 3456
#define XB_SPIN_CAP (1u << 18)

__device__ __forceinline__ unsigned xb_ld(unsigned* p)              { return __hip_atomic_load(p, __ATOMIC_RELAXED, __HIP_MEMORY_SCOPE_AGENT); }
__device__ __forceinline__ unsigned xb_add(unsigned* p, unsigned v) { return __hip_atomic_fetch_add(p, v, __ATOMIC_RELAXED, __HIP_MEMORY_SCOPE_AGENT); }
__device__ __forceinline__ unsigned xb_xcc_id() { return (unsigned)__builtin_amdgcn_s_getreg((3 << 11) | 20) & 0xFu; }
#define XB_SPIN(cond, bar) do { unsigned _sp = 0; while (cond) { __builtin_amdgcn_s_sleep(1); \
    if ((++_sp & 255u) == 0u) { if (xb_ld(&(bar)[XB_TMO])) break; if (_sp > XB_SPIN_CAP) { atomicAdd(&(bar)[XB_TMO], 1u); break; } } } } while (0)

struct XcdBarrier {
    unsigned* bar; unsigned x;
    volatile LAS unsigned* st;
};

__device__ __forceinline__ XcdBarrier xcd_barrier_post(unsigned* bar, volatile LAS unsigned* st) {
    XcdBarrier b; b.bar = bar; b.x = xb_xcc_id(); b.st = st;
    if (threadIdx.x == 0) (void)xb_add(&bar[XB_XCNT(b.x)], 1u);
    return b;
}
__device__ __forceinline__ void xcd_barrier_complete(unsigned* bar, unsigned x, unsigned& nloc, unsigned& nx) {
    const unsigned G = gridDim.x * gridDim.y * gridDim.z;
    unsigned sum, cnt, mine, sp = 0u;
    for (;;) {
        sum = 0u; cnt = 0u; mine = 0u;
#pragma unroll
        for (unsigned j = 0; j < 16; ++j) { const unsigned c = xb_ld(&bar[XB_XCNT(j)]); sum += c; cnt += (c > 0u) ? 1u : 0u; mine = (j == x) ? c : mine; }
        if (sum == G) break;
        __builtin_amdgcn_s_sleep(1);
        if ((++sp & 255u) == 0u) { if (xb_ld(&bar[XB_TMO])) break; if (sp > XB_SPIN_CAP) { atomicAdd(&bar[XB_TMO], 1u); break; } }
    }
    nloc = mine > 0u ? mine : 1u; nx = cnt > 0u ? cnt : 1u;
}

__device__ __forceinline__ void xcd_barrier(const XcdBarrier& b) {
    asm volatile("s_waitcnt vmcnt(0)" ::: "memory");
    __syncthreads();
    if (threadIdx.x == 0) {
        unsigned* bar = b.bar;
        __builtin_amdgcn_s_waitcnt(0);
        unsigned nloc = b.st[0], nx = b.st[1];
        if (nloc == 0u) { xcd_barrier_complete(bar, b.x, nloc, nx); b.st[0] = nloc; b.st[1] = nx; }
        const unsigned old = xb_add(&bar[XB_XSUB(b.x)], 1u);
        const unsigned gen = old / nloc;
        if (old + 1u == (gen + 1u) * nloc) {
            __builtin_amdgcn_fence(__ATOMIC_RELEASE, "agent");
            asm volatile("s_waitcnt vmcnt(0)" ::: "memory");
            const unsigned og = xb_add(&bar[XB_TOP], 1u);
            const unsigned tg = og / nx;
            if (og + 1u == (tg + 1u) * nx) xb_add(&bar[XB_TOPGEN], 1u);
            else XB_SPIN(xb_ld(&bar[XB_TOPGEN]) == tg, bar);
            __builtin_amdgcn_fence(__ATOMIC_ACQUIRE, "agent");
            xb_add(&bar[XB_XGEN(b.x)], 1u);
            asm volatile("s_waitcnt vmcnt(0)" ::: "memory");
        } else {
            XB_SPIN(xb_ld(&bar[XB_XGEN(b.x)]) == gen, bar);
            __builtin_amdgcn_fence(__ATOMIC_ACQUIRE, "agent");
            asm volatile("s_waitcnt vmcnt(0)" ::: "memory");
        }
    }
    __syncthreads();
}
typedef unsigned u32x4 __attribute__((ext_vector_type(4)));

constexpr int RING_OFF = 0, RING_BYTES = 147456;
constexpr int LDSCTL_OFF = RING_BYTES, MISC_OFF = LDSCTL_OFF + 320;
constexpr int LDS_BYTES = RING_BYTES + 1024;

struct Frame {
    LAS unsigned char* lds;
    volatile LAS unsigned* MISC;
    int tid, lane, wave, vcu, G;
};

__device__ __forceinline__ float wave_sum(float v) {
#pragma unroll
    for (int o = 1; o < 64; o <<= 1) v += __shfl_xor(v, o);
    return v;
}
__device__ __forceinline__ int src_col_w1(int n) {
    if (n < 1152) { const int hh = n >> 6, p = n & 63; return hh * 64 + 4 * (p >> 3) + (p & 3) + 32 * ((p >> 2) & 1); }
    if (n < 5376) return n;
    return n + 16;
}
__device__ __forceinline__ void p0_transpose_item(const float* W, int ldw, int K, bf16* WT, int n0, int k0, int srccol, LAS float* scr, int lane) {
    float tv[32];
#pragma unroll
    for (int i = 0; i < 32; ++i) { const int kk = 2 * i + (lane >> 5); tv[i] = W[(size_t)(k0 + kk) * ldw + srccol]; }
#pragma unroll
    for (int i = 0; i < 32; ++i) { const int kk = 2 * i + (lane >> 5); scr[kk * 33 + (lane & 31)] = tv[i]; }
    LDS_WAIT(); asm volatile("" ::: "memory");
    const int c = lane & 7;
#pragma unroll
    for (int j = 0; j < 4; ++j) { const int n = (lane >> 3) + 8 * j; const LAS float* s = scr + (8 * c) * 33 + n;
        v4u o; o.x = pk2(s[0 * 33], s[1 * 33]); o.y = pk2(s[2 * 33], s[3 * 33]); o.z = pk2(s[4 * 33], s[5 * 33]); o.w = pk2(s[6 * 33], s[7 * 33]);
        *(GAS v4u*)(WT + (size_t)(n0 + n) * K + k0 + 8 * c) = o; }
    LDS_WAIT(); asm volatile("" ::: "memory");
}
__device__ __forceinline__ void p0_fold_item(const float* W, const float* up, bf16* WT, int e0, int k0, LAS float* scr, int lane) {
    float u[16];
#pragma unroll
    for (int r = 0; r < 16; ++r) u[r] = up[r * 512 + e0 + (lane & 31)];
#pragma unroll 4
    for (int i = 0; i < 32; ++i) { const int kk = 2 * i + (lane >> 5); const float* wr = W + (size_t)(k0 + kk) * INW + 5376; float a = 0.f;
#pragma unroll
        for (int r = 0; r < 16; ++r) a = fmaf(wr[r], u[r], a);
        scr[kk * 33 + (lane & 31)] = a; }
    LDS_WAIT(); asm volatile("" ::: "memory");
    const int c = lane & 7;
#pragma unroll
    for (int j = 0; j < 4; ++j) { const int n = (lane >> 3) + 8 * j; const LAS float* s = scr + (8 * c) * 33 + n;
        v4u o; o.x = pk2(s[0 * 33], s[1 * 33]); o.y = pk2(s[2 * 33], s[3 * 33]); o.z = pk2(s[4 * 33], s[5 * 33]); o.w = pk2(s[6 * 33], s[7 * 33]);
        *(GAS v4u*)(WT + (size_t)(7424 + e0 + n) * 1024 + k0 + 8 * c) = o; }
    LDS_WAIT(); asm volatile("" ::: "memory");
}
__device__ __forceinline__ void rms_row_to_bf16(int lane, const float* xrow, const float* w, bf16* orow) {
    const GAS f32x4* xr = (const GAS f32x4*)xrow + lane; const GAS f32x4* wr = (const GAS f32x4*)w + lane;
    f32x4 v[4]; float s = 0.f;
#pragma unroll
    for (int j = 0; j < 4; ++j) { v[j] = xr[64 * j]; s += (v[j].x * v[j].x + v[j].y * v[j].y) + (v[j].z * v[j].z + v[j].w * v[j].w); }
    const float rstd = 1.f / sqrtf(wave_sum(s) * (1.f / D) + EPS);
    GAS unsigned long long* o8 = (GAS unsigned long long*)orow + lane;
#pragma unroll
    for (int j = 0; j < 4; ++j) { const f32x4 ww = wr[64 * j];
        o8[64 * j] = (unsigned long long)pk2(v[j].x * rstd * ww.x, v[j].y * rstd * ww.y) | ((unsigned long long)pk2(v[j].z * rstd * ww.z, v[j].w * rstd * ww.w) << 32); }
}

__device__ __forceinline__ void rms_rows4_to_bf16(int lane, const float* x, const float* w, bf16* out, int m0, int stride) {
    f32x4 v[4][4]; float s[4];
#pragma unroll
    for (int r = 0; r < 4; ++r) { const int m = m0 + r * stride; const GAS f32x4* xr = (const GAS f32x4*)(x + (size_t)(m < M ? m : m0) * D) + lane;
#pragma unroll
        for (int j = 0; j < 4; ++j) v[r][j] = xr[64 * j]; }
    const GAS f32x4* wr = (const GAS f32x4*)w + lane;
    f32x4 ww[4];
#pragma unroll
    for (int j = 0; j < 4; ++j) ww[j] = wr[64 * j];
#pragma unroll
    for (int r = 0; r < 4; ++r) { float a = 0.f;
#pragma unroll
        for (int j = 0; j < 4; ++j) a += (v[r][j].x * v[r][j].x + v[r][j].y * v[r][j].y) + (v[r][j].z * v[r][j].z + v[r][j].w * v[r][j].w);
        s[r] = a; }
#pragma unroll
    for (int o = 1; o < 64; o <<= 1) {
#pragma unroll
        for (int r = 0; r < 4; ++r) s[r] += __shfl_xor(s[r], o); }
#pragma unroll
    for (int r = 0; r < 4; ++r) { const int m = m0 + r * stride; if (m < M) { const float rstd = 1.f / sqrtf(s[r] * (1.f / D) + EPS);
        GAS unsigned long long* o8 = (GAS unsigned long long*)(out + (size_t)m * D) + lane;
#pragma unroll
        for (int j = 0; j < 4; ++j) o8[64 * j] = (unsigned long long)pk2(v[r][j].x * rstd * ww[j].x, v[r][j].y * rstd * ww[j].y) | ((unsigned long long)pk2(v[r][j].z * rstd * ww[j].z, v[r][j].w * rstd * ww[j].w) << 32); } }
}
typedef float f32x16 __attribute__((ext_vector_type(16)));
typedef short s16x4 __attribute__((ext_vector_type(4)));
typedef unsigned u32x2 __attribute__((ext_vector_type(2)));
__device__ __forceinline__ int crow(int r, int hi) { return (r & 3) + 8 * (r >> 2) + 4 * hi; }
constexpr int AT_KSTR = 144, AT_VSTR = 520, AT_K = 0, AT_V = 256 * AT_KSTR, AT_W = AT_V + 64 * AT_VSTR, AT_WB = 2 * 32 * 144;
static_assert(AT_W + 8 * AT_WB <= RING_BYTES && (AT_W % 16) == 0, "attention LDS");
__device__ __forceinline__ void attn_unit(LAS unsigned char* lds, int b, int nb, int g, const bf16* Q, const bf16* KV, bf16* AGO, const float* sinks) {
    const int tid = threadIdx.x, lane = tid & 63, r32 = lane & 31, hi = lane >> 5; const int wid = __builtin_amdgcn_readfirstlane(tid >> 6);
    const long tok0 = (long)b * T + nb * 128, key0 = tok0 - 128;
    const int jlo = nb > 0 ? 0 : 128;
#pragma unroll
    for (int i = 0; i < 4; ++i) { const int p = tid + 512 * i, key = p >> 3, ch = p & 7;
        if (key >= jlo) { const v4u v = *(const GAS v4u*)(KV + (key0 + key) * 256 + g * 64 + ch * 8); *(LAS v4u*)(lds + AT_K + key * AT_KSTR + ch * 16) = v; } }
#pragma unroll
    for (int i = 0; i < 4; ++i) { const int p = tid + 512 * i, key = p & 255, ch = p >> 8;
        if (key >= jlo) { const v4u v = *(const GAS v4u*)(KV + (key0 + key) * 256 + 128 + g * 64 + ch * 8);
            LAS unsigned short* vt = (LAS unsigned short*)(lds + AT_V + (ch * 8) * AT_VSTR + key * 2);
            vt[0 * (AT_VSTR / 2)] = (unsigned short)(v.x & 0xffff); vt[1 * (AT_VSTR / 2)] = (unsigned short)(v.x >> 16);
            vt[2 * (AT_VSTR / 2)] = (unsigned short)(v.y & 0xffff); vt[3 * (AT_VSTR / 2)] = (unsigned short)(v.y >> 16);
            vt[4 * (AT_VSTR / 2)] = (unsigned short)(v.z & 0xffff); vt[5 * (AT_VSTR / 2)] = (unsigned short)(v.z >> 16);
            vt[6 * (AT_VSTR / 2)] = (unsigned short)(v.w & 0xffff); vt[7 * (AT_VSTR / 2)] = (unsigned short)(v.w >> 16); } }
    __syncthreads();
    const int hq = g * 8 + wid; const float sink2 = sinks[hq] * 1.4426950408889634f;
    const float NEG = -INFINITY;
    LAS unsigned char* wq = lds + AT_W + wid * AT_WB; LAS unsigned char* wg = wq + 32 * 144;
    const int srow = lane >> 3, spc = lane & 7;
    u32x4 qn[4], gn[4];
#pragma unroll
    for (int j = 0; j < 4; ++j) { const long rq = (tok0 + 8 * j + srow) * 1024 + hq * 64 + spc * 8, rg = (tok0 + 8 * j + srow) * 2048 + hq * 64 + spc * 8; qn[j] = *(const GAS u32x4*)(Q + rq); gn[j] = *(const GAS u32x4*)(AGO + rg); }
    for (int R = 0; R < 4; ++R) {
        const long qtok = tok0 + 32 * R + r32;
#pragma unroll
        for (int j = 0; j < 4; ++j) { *(LAS u32x4*)(wq + (8 * j + srow) * 144 + spc * 16) = qn[j]; *(LAS u32x4*)(wg + (8 * j + srow) * 144 + spc * 16) = gn[j]; }
        if (R < 3) {
#pragma unroll
            for (int j = 0; j < 4; ++j) { const long rq = (tok0 + 32 * (R + 1) + 8 * j + srow) * 1024 + hq * 64 + spc * 8, rg = (tok0 + 32 * (R + 1) + 8 * j + srow) * 2048 + hq * 64 + spc * 8; qn[j] = *(const GAS u32x4*)(Q + rq); gn[j] = *(const GAS u32x4*)(AGO + rg); }
        }
        bf16x8 qf[4];
#pragma unroll
        for (int s = 0; s < 4; ++s) qf[s] = *(const LAS bf16x8*)(wq + r32 * 144 + (16 * s + 8 * hi) * 2);
        f32x16 st[5];
#pragma unroll
        for (int tt = 0; tt < 5; ++tt) {
            const int Tt = R + tt; const bool active = (nb > 0) || (Tt >= 4);
#pragma unroll
            for (int r = 0; r < 16; ++r) st[tt][r] = 0.f;
            if (active) {
                bf16x8 kf4[4];
#pragma unroll
                for (int s = 0; s < 4; ++s) kf4[s] = *(const LAS bf16x8*)(lds + AT_K + (32 * Tt + r32) * AT_KSTR + (16 * s + 8 * hi) * 2);
                __builtin_amdgcn_s_setprio(1);
#pragma unroll
                for (int s = 0; s < 4; ++s) st[tt] = __builtin_amdgcn_mfma_f32_32x32x16_bf16(kf4[s], qf[s], st[tt], 0, 0, 0);
                __builtin_amdgcn_s_setprio(0);
            } else {
#pragma unroll
                for (int r = 0; r < 16; ++r) st[tt][r] = NEG;
            }
        }
#pragma unroll
        for (int r = 0; r < 16; ++r) { const int cr = crow(r, hi); if (!(cr > r32)) st[0][r] = NEG; if (!(cr <= r32)) st[4][r] = NEG; }
        float mx = sink2;
#pragma unroll
        for (int tt = 0; tt < 5; ++tt)
#pragma unroll
            for (int r = 0; r < 16; ++r) mx = fmaxf(mx, st[tt][r]);
        mx = fmaxf(mx, __shfl_xor(mx, 32));
        float l = 0.f;
#pragma unroll
        for (int tt = 0; tt < 5; ++tt)
#pragma unroll
            for (int r = 0; r < 16; ++r) { const float p = __builtin_amdgcn_exp2f(st[tt][r] - mx); st[tt][r] = p; l += p; }
        l += __shfl_xor(l, 32); l += __builtin_amdgcn_exp2f(sink2 - mx);
        const float inv_l = 1.0f / l;
        f32x16 o[2];
#pragma unroll
        for (int r = 0; r < 16; ++r) { o[0][r] = 0.f; o[1][r] = 0.f; }
#pragma unroll
        for (int tt = 0; tt < 5; ++tt) {
            const int Tt = R + tt; const bool active = (nb > 0) || (Tt >= 4);
            if (active) {
#pragma unroll
                for (int s = 0; s < 2; ++s) {
                    u32x4 pw; pw.x = pg8::cvt_pk_bf16(st[tt][8 * s + 0], st[tt][8 * s + 1]); pw.y = pg8::cvt_pk_bf16(st[tt][8 * s + 2], st[tt][8 * s + 3]);
                    pw.z = pg8::cvt_pk_bf16(st[tt][8 * s + 4], st[tt][8 * s + 5]); pw.w = pg8::cvt_pk_bf16(st[tt][8 * s + 6], st[tt][8 * s + 7]);
                    const bf16x8 pf = __builtin_bit_cast(bf16x8, pw);
#pragma unroll
                    for (int db = 0; db < 2; ++db) {
                        const LAS unsigned char* vp = lds + AT_V + (32 * db + r32) * AT_VSTR + (32 * Tt + 16 * s + 4 * hi) * 2;
                        const u32x2 a0 = *(const LAS u32x2*)vp, a1 = *(const LAS u32x2*)(vp + 16);
                        const u32x4 aw = (u32x4){a0.x, a0.y, a1.x, a1.y};
                        o[db] = __builtin_amdgcn_mfma_f32_32x32x16_bf16(__builtin_bit_cast(bf16x8, aw), pf, o[db], 0, 0, 0);
                    }
                }
            }
        }
#pragma unroll
        for (int db = 0; db < 2; ++db)
#pragma unroll
            for (int g4 = 0; g4 < 4; ++g4) {
                LAS u32x2* p = (LAS u32x2*)(wg + r32 * 144 + (32 * db + 8 * g4 + 4 * hi) * 2);
                const u32x2 gw = *p;
                u32x2 ow; ow.x = pg8::cvt_pk_bf16(o[db][4 * g4 + 0] * inv_l * pg8::bf_lo(gw.x), o[db][4 * g4 + 1] * inv_l * pg8::bf_hi(gw.x));
                ow.y = pg8::cvt_pk_bf16(o[db][4 * g4 + 2] * inv_l * pg8::bf_lo(gw.y), o[db][4 * g4 + 3] * inv_l * pg8::bf_hi(gw.y));
                *p = ow;
            }
#pragma unroll
        for (int j = 0; j < 4; ++j) { const u32x4 v = *(const LAS u32x4*)(wg + (8 * j + srow) * 144 + spc * 16);
            *(GAS u32x4*)(AGO + (tok0 + 32 * R + 8 * j + srow) * 2048 + hq * 64 + spc * 8) = v; }
    }
    __syncthreads();
}

typedef float f32x2 __attribute__((ext_vector_type(2)));
constexpr int G1_QSTR = 272;
constexpr int G1_QE = 0, G1_KE = G1_QE + 64 * G1_QSTR, G1_SEG = G1_KE + 64 * G1_QSTR, G1_END = G1_SEG + 4096;
struct PSet { f32x2 la2[8]; unsigned q2[8], k2[8]; };
__device__ __forceinline__ void pset_load(PSet& p, int b, int h, int n, int w, int c2, const bf16* BQ, const bf16* BK, const float* LOGA) {
    const long tk = (long)b * T + n * 64;
#pragma unroll
    for (int i = 0; i < 8; ++i) { const long ro = (tk + 8 * w + i) * 512 + h * 128 + 2 * c2;
        p.la2[i] = *(const GAS f32x2*)(LOGA + ro); p.q2[i] = *(const GAS unsigned*)(BQ + ro); p.k2[i] = *(const GAS unsigned*)(BK + ro); }
}
__device__ __forceinline__ void gla_pre_item(PSet& p, LAS unsigned char* lds, int bh, int n, bf16* BQ, bf16* BK, bf16* ATTG, float* DECG) {
    const int tid = threadIdx.x, lane = tid & 63, r32 = lane & 31, hi = lane >> 5; const int w = __builtin_amdgcn_readfirstlane(tid >> 6);
    const int b = bh >> 2, h = bh & 3, c2 = tid & 63;
    LAS f32x2* SEG = (LAS f32x2*)(lds + G1_SEG);
    const long tokc = (long)b * T + n * 64;
#pragma unroll
    for (int i = 1; i < 8; ++i) p.la2[i] += p.la2[i - 1];
    SEG[w * 64 + c2] = p.la2[7];
    __syncthreads();
    f32x2 off = (f32x2){0.f, 0.f}, bl = (f32x2){0.f, 0.f};
#pragma unroll
    for (int s = 0; s < 8; ++s) { const f32x2 v = SEG[s * 64 + c2]; bl += v; if (s < w) off += v; }
    const float decx = __expf(bl.x), decy = __expf(bl.y);
    if (w == 0) __hip_atomic_store((unsigned long long*)(DECG + ((long)bh * 32 + n) * 128 + 2 * c2), ((unsigned long long)__float_as_uint(decy) << 32) | __float_as_uint(decx), __ATOMIC_RELAXED, __HIP_MEMORY_SCOPE_AGENT);
#pragma unroll
    for (int i = 0; i < 8; ++i) {
        const float bx = off.x + p.la2[i].x, by = off.y + p.la2[i].y;
        const float ex = __expf(bx), ey = __expf(by), iex = __builtin_amdgcn_rcpf(ex), iey = __builtin_amdgcn_rcpf(ey);
        const float qx = pg8::bf_lo(p.q2[i]) * 0.08838834764831845f * ex, qy = pg8::bf_hi(p.q2[i]) * 0.08838834764831845f * ey;
        const float kx = pg8::bf_lo(p.k2[i]) * iex, ky = pg8::bf_hi(p.k2[i]) * iey;
        const unsigned qw = pg8::cvt_pk_bf16(qx, qy);
        const long ro = (tokc + 8 * w + i) * 512 + h * 128 + 2 * c2;
        *(LAS unsigned*)(lds + G1_QE + (8 * w + i) * G1_QSTR + c2 * 4) = qw;
        *(LAS unsigned*)(lds + G1_KE + (8 * w + i) * G1_QSTR + c2 * 4) = pg8::cvt_pk_bf16(kx, ky);
        __hip_atomic_store((unsigned*)(BQ + ro), qw, __ATOMIC_RELAXED, __HIP_MEMORY_SCOPE_AGENT);
        __hip_atomic_store((unsigned*)(BK + ro), pg8::cvt_pk_bf16(kx * decx, ky * decy), __ATOMIC_RELAXED, __HIP_MEMORY_SCOPE_AGENT);
    }
    __syncthreads();
    if (w < 3) {
        const int Ia = (w + 1) >> 1, Ja = w >> 1;
        f32x16 a;
#pragma unroll
        for (int r = 0; r < 16; ++r) a[r] = 0.f;
#pragma unroll
        for (int s = 0; s < 8; ++s) {
            const bf16x8 kf = *(const LAS bf16x8*)(lds + G1_KE + (32 * Ja + r32) * G1_QSTR + (16 * s + 8 * hi) * 2);
            const bf16x8 qf = *(const LAS bf16x8*)(lds + G1_QE + (32 * Ia + r32) * G1_QSTR + (16 * s + 8 * hi) * 2);
            a = __builtin_amdgcn_mfma_f32_32x32x16_bf16(kf, qf, a, 0, 0, 0);
        }
        bf16* ap = ATTG + (((long)bh * 32 + n) * 64 + 32 * Ia + r32) * 64 + 32 * Ja + 4 * hi;
#pragma unroll
        for (int g4 = 0; g4 < 4; ++g4) {
            float v[4];
#pragma unroll
            for (int e = 0; e < 4; ++e) { const int jj = 32 * Ja + 8 * g4 + 4 * hi + e, ii = 32 * Ia + r32; v[e] = (jj <= ii) ? a[4 * g4 + e] : 0.f; }
            u32x2 ow; ow.x = pg8::cvt_pk_bf16(v[0], v[1]); ow.y = pg8::cvt_pk_bf16(v[2], v[3]);
            __hip_atomic_store((unsigned long long*)(ap + 8 * g4), ((unsigned long long)ow.y << 32) | ow.x, __ATOMIC_RELAXED, __HIP_MEMORY_SCOPE_AGENT);
        }
    }
    __syncthreads();
}
__device__ __forceinline__ void gla_pre(LAS unsigned char* lds, int bh, int n0, int cnt, bf16* BQ, bf16* BK, const float* LOGA, bf16* ATTG, float* DECG) {
    const int tid = threadIdx.x; const int w = __builtin_amdgcn_readfirstlane(tid >> 6); const int b = bh >> 2, h = bh & 3, c2 = tid & 63;
    PSet A, B;
    pset_load(A, b, h, n0, w, c2, BQ, BK, LOGA);
    for (int j = 0; j < cnt; j += 2) {
        if (j + 1 < cnt) pset_load(B, b, h, n0 + j + 1, w, c2, BQ, BK, LOGA);
        gla_pre_item(A, lds, bh, n0 + j, BQ, BK, ATTG, DECG);
        if (j + 1 < cnt) {
            if (j + 2 < cnt) pset_load(A, b, h, n0 + j + 2, w, c2, BQ, BK, LOGA);
            gla_pre_item(B, lds, bh, n0 + j + 1, BQ, BK, ATTG, DECG);
        }
    }
}
constexpr int G2_TSTR = 144, G2_QSTR = 272;
constexpr int G2_KST = 0, G2_VT = G2_KST + 128 * G2_TSTR, G2_QE = G2_VT + 32 * G2_TSTR, G2_ATT = G2_QE + 64 * G2_QSTR, G2_OP = G2_ATT + 64 * G2_TSTR, G2_SSQ = G2_OP + 32768, G2_END = G2_SSQ + 1024;
static_assert(G2_END <= RING_BYTES && (G2_QE % 16) == 0 && (G2_ATT % 16) == 0 && (G2_OP % 16) == 0 && G1_END <= RING_BYTES, "GLA LDS");
#ifdef PROBE_PHASE
#define GLA_T(k) do { if (blockIdx.x == 0 && c.tid == 0) { const unsigned t_ = (unsigned)__builtin_amdgcn_s_memrealtime(); volatile LAS unsigned* M_ = (volatile LAS unsigned*)(lds + MISC_OFF); \
        if ((k) > 0) M_[26 + (k)] += t_ - M_[26]; M_[26] = t_; } } while (0)
#else
#define GLA_T(k) do {} while (0)
#endif
struct GSet { unsigned ks2[8]; u32x2 vq; u32x4 qe[2]; u32x4 att; f32x4 dec[4]; };
struct GCtx { const bf16* QE; const bf16* KS; const bf16* BV; const bf16* ATTG; const float* DECG; bf16* OBU; float* SSB; int bh, sl, b, h, kb, I, c2, vtok, vd4, w, lane, r32, hi, tid; bool has_intra; };
__device__ __forceinline__ void gset_load(GSet& s, const GCtx& c, int n) {
    const long tk = (long)c.b * T + n * 64; const long it = (long)c.bh * 32 + n;
    s.vq = *(const GAS u32x2*)(c.BV + (tk + c.vtok) * 1024 + c.h * 256 + 32 * c.sl + c.vd4);
#pragma unroll
    for (int i = 0; i < 8; ++i) s.ks2[i] = *(const GAS unsigned*)(c.KS + (tk + 8 * c.w + i) * 512 + c.h * 128 + 2 * c.c2);
#pragma unroll
    for (int j = 0; j < 2; ++j) { const int p = c.tid + 512 * j; s.qe[j] = *(const GAS u32x4*)(c.QE + (tk + (p >> 4)) * 512 + c.h * 128 + (p & 15) * 8); }
    s.att = *(const GAS u32x4*)(c.ATTG + (it * 64 + (c.tid >> 3)) * 64 + (c.tid & 7) * 8);
#pragma unroll
    for (int g = 0; g < 4; ++g) s.dec[g] = *(const GAS f32x4*)(c.DECG + it * 128 + 32 * c.kb + 8 * g + 4 * c.hi);
}
__device__ __forceinline__ void gla_chunk(GSet& s, const GCtx& c, int n, f32x16& S, LAS unsigned char* lds) {
    const long tokc = (long)c.b * T + n * 64;
    LAS unsigned char* buf = lds;
    LAS float* SSQ = (LAS float*)(lds + G2_SSQ);
    const int kb = c.kb, I = c.I, r32 = c.r32, hi = c.hi, lane = c.lane;
    u32x4 sw[2];
#pragma unroll
    for (int s2 = 0; s2 < 2; ++s2) { sw[s2].x = pg8::cvt_pk_bf16(S[8 * s2 + 0], S[8 * s2 + 1]); sw[s2].y = pg8::cvt_pk_bf16(S[8 * s2 + 2], S[8 * s2 + 3]);
        sw[s2].z = pg8::cvt_pk_bf16(S[8 * s2 + 4], S[8 * s2 + 5]); sw[s2].w = pg8::cvt_pk_bf16(S[8 * s2 + 6], S[8 * s2 + 7]); }
#pragma unroll
    for (int r = 0; r < 16; ++r) S[r] *= s.dec[r >> 2][r & 3];
    asm volatile("" : "+v"(S));
    GLA_T(0);
    {
        v4u kx, ky;
        kx.x = (s.ks2[0] & 0xffffu) | (s.ks2[1] << 16); kx.y = (s.ks2[2] & 0xffffu) | (s.ks2[3] << 16); kx.z = (s.ks2[4] & 0xffffu) | (s.ks2[5] << 16); kx.w = (s.ks2[6] & 0xffffu) | (s.ks2[7] << 16);
        ky.x = (s.ks2[0] >> 16) | (s.ks2[1] & 0xffff0000u); ky.y = (s.ks2[2] >> 16) | (s.ks2[3] & 0xffff0000u); ky.z = (s.ks2[4] >> 16) | (s.ks2[5] & 0xffff0000u); ky.w = (s.ks2[6] >> 16) | (s.ks2[7] & 0xffff0000u);
        *(LAS v4u*)(buf + G2_KST + (2 * c.c2) * G2_TSTR + 16 * c.w) = kx;
        *(LAS v4u*)(buf + G2_KST + (2 * c.c2 + 1) * G2_TSTR + 16 * c.w) = ky;
        LAS unsigned short* vt = (LAS unsigned short*)(buf + G2_VT + c.vd4 * G2_TSTR + c.vtok * 2);
        vt[0] = (unsigned short)(s.vq.x & 0xffff); vt[G2_TSTR / 2] = (unsigned short)(s.vq.x >> 16);
        vt[2 * (G2_TSTR / 2)] = (unsigned short)(s.vq.y & 0xffff); vt[3 * (G2_TSTR / 2)] = (unsigned short)(s.vq.y >> 16);
#pragma unroll
        for (int j = 0; j < 2; ++j) { const int p = c.tid + 512 * j; *(LAS u32x4*)(buf + G2_QE + (p >> 4) * G2_QSTR + (p & 15) * 16) = s.qe[j]; }
        *(LAS u32x4*)(buf + G2_ATT + (c.tid >> 3) * G2_TSTR + (c.tid & 7) * 16) = s.att;
    }
    __syncthreads();
    GLA_T(1);
    if (n > 0 && c.tid < 64) { const float q = (SSQ[c.tid] + SSQ[64 + c.tid]) + (SSQ[128 + c.tid] + SSQ[192 + c.tid]);
        __hip_atomic_fetch_add(c.SSB + (tokc - 64 + c.tid) * 4 + c.h, q, __ATOMIC_RELAXED, __HIP_MEMORY_SCOPE_AGENT); }
    f32x16 oT;
#pragma unroll
    for (int r = 0; r < 16; ++r) oT[r] = 0.f;
#pragma unroll
    for (int s2 = 0; s2 < 2; ++s2) {
        const LAS unsigned char* qp = buf + G2_QE + (32 * I + r32) * G2_QSTR + (32 * kb + 16 * s2 + 4 * hi) * 2;
        const u32x2 a0 = *(const LAS u32x2*)qp, a1 = *(const LAS u32x2*)(qp + 16);
        const u32x4 qw = (u32x4){a0.x, a0.y, a1.x, a1.y};
        oT = __builtin_amdgcn_mfma_f32_32x32x16_bf16(__builtin_bit_cast(bf16x8, sw[s2]), __builtin_bit_cast(bf16x8, qw), oT, 0, 0, 0);
    }
    bf16x8 vf[4];
#pragma unroll
    for (int k = 0; k < 4; ++k) vf[k] = *(const LAS bf16x8*)(buf + G2_VT + r32 * G2_TSTR + (16 * k + 8 * hi) * 2);
#pragma unroll
    for (int k = 0; k < 4; ++k) {
        const bf16x8 kf = *(const LAS bf16x8*)(buf + G2_KST + (32 * kb + r32) * G2_TSTR + (16 * k + 8 * hi) * 2);
        S = __builtin_amdgcn_mfma_f32_32x32x16_bf16(kf, vf[k], S, 0, 0, 0);
    }
    if (c.has_intra) {
        const bf16x8 vk = *(const LAS bf16x8*)(buf + G2_VT + r32 * G2_TSTR + (16 * kb + 8 * hi) * 2);
        const bf16x8 af = *(const LAS bf16x8*)(buf + G2_ATT + (32 * I + r32) * G2_TSTR + (16 * kb + 8 * hi) * 2);
        oT = __builtin_amdgcn_mfma_f32_32x32x16_bf16(vk, af, oT, 0, 0, 0);
    }
    if (n + 2 < 32) gset_load(s, c, n + 2);
#pragma unroll
    for (int g4 = 0; g4 < 4; ++g4) *(LAS f32x4*)(lds + G2_OP + (((kb * 2 + I) * 4 + g4) * 64 + lane) * 16) = (f32x4){oT[4 * g4], oT[4 * g4 + 1], oT[4 * g4 + 2], oT[4 * g4 + 3]};
    __syncthreads();
    GLA_T(2);
    f32x4 v = *(const LAS f32x4*)(lds + G2_OP + (((0 * 2 + I) * 4 + kb) * 64 + lane) * 16);
#pragma unroll
    for (int kw = 1; kw < 4; ++kw) v += *(const LAS f32x4*)(lds + G2_OP + (((kw * 2 + I) * 4 + kb) * 64 + lane) * 16);
    { u32x2 ow; ow.x = pg8::cvt_pk_bf16(v[0], v[1]); ow.y = pg8::cvt_pk_bf16(v[2], v[3]);
      __hip_atomic_store((unsigned long long*)(c.OBU + (tokc + 32 * I + r32) * 1024 + c.h * 256 + 32 * c.sl + 8 * kb + 4 * hi), ((unsigned long long)ow.y << 32) | ow.x, __ATOMIC_RELAXED, __HIP_MEMORY_SCOPE_AGENT); }
    float ss = (v[0] * v[0] + v[1] * v[1]) + (v[2] * v[2] + v[3] * v[3]);
    ss += __shfl_xor(ss, 32);
    if (hi == 0) SSQ[kb * 64 + 32 * I + r32] = ss;
    GLA_T(3);
}
__device__ __forceinline__ void gla_serial(LAS unsigned char* lds, int bh, int sl, const bf16* QE, const bf16* KS, const bf16* BV, const bf16* ATTG, const float* DECG, bf16* OBU, float* SSB) {
    GCtx c; c.QE = QE; c.KS = KS; c.BV = BV; c.ATTG = ATTG; c.DECG = DECG; c.OBU = OBU; c.SSB = SSB; c.bh = bh; c.sl = sl; c.b = bh >> 2; c.h = bh & 3;
    c.tid = threadIdx.x; c.lane = c.tid & 63; c.r32 = c.lane & 31; c.hi = c.lane >> 5; c.w = __builtin_amdgcn_readfirstlane(c.tid >> 6);
    c.kb = c.w & 3; c.I = c.w >> 2; c.c2 = c.tid & 63; c.vtok = c.tid >> 3; c.vd4 = (c.tid & 7) * 4; c.has_intra = (c.I == 1) || (c.kb < 2);
    f32x16 S;
#pragma unroll
    for (int r = 0; r < 16; ++r) S[r] = 0.f;
    GSet A, B;
    gset_load(A, c, 0); gset_load(B, c, 1);
    for (int n = 0; n < 32; n += 2) { gla_chunk(A, c, n, S, lds); gla_chunk(B, c, n + 1, S, lds); }
    __syncthreads();
    LAS float* SSQ = (LAS float*)(lds + G2_SSQ);
    if (c.tid < 64) { const float q = (SSQ[c.tid] + SSQ[64 + c.tid]) + (SSQ[128 + c.tid] + SSQ[192 + c.tid]);
        __hip_atomic_fetch_add(SSB + ((long)c.b * T + 31 * 64 + c.tid) * 4 + c.h, q, __ATOMIC_RELAXED, __HIP_MEMORY_SCOPE_AGENT); }
    __syncthreads();
}

__device__ __forceinline__ void gla_norm_rows(int bh, int t0, int cnt, int wave, int nwaves, int lane, const bf16* OBU, bf16* BG, const float* SSB, const float* nw) {
    const int b = bh >> 2, h = bh & 3;
    const f32x4 w4 = *(const GAS f32x4*)(nw + 4 * lane);
    constexpr int NB = 16;
    for (int tb = t0 + wave; tb < t0 + cnt; tb += nwaves * NB) {
        float ssv[NB]; u32x2 ov[NB], gv[NB];
#pragma unroll
        for (int j = 0; j < NB; ++j) { const int t = tb + j * nwaves; const long tok = (long)b * T + (t < t0 + cnt ? t : t0);
            ssv[j] = __hip_atomic_load(SSB + tok * 4 + h, __ATOMIC_RELAXED, __HIP_MEMORY_SCOPE_AGENT);
            ov[j] = *(const GAS u32x2*)(OBU + tok * 1024 + h * 256 + 4 * lane); gv[j] = *(const GAS u32x2*)(BG + tok * 2048 + h * 256 + 4 * lane); }
#pragma unroll
        for (int j = 0; j < NB; ++j) { const int t = tb + j * nwaves;
            if (t < t0 + cnt) { const long tok = (long)b * T + t;
                const float rstd = 1.0f / sqrtf(ssv[j] * (1.0f / 256.0f) + EPS);
                u32x2 r; r.x = pg8::cvt_pk_bf16(pg8::bf_lo(ov[j].x) * rstd * w4[0] * pg8::bf_lo(gv[j].x), pg8::bf_hi(ov[j].x) * rstd * w4[1] * pg8::bf_hi(gv[j].x));
                r.y = pg8::cvt_pk_bf16(pg8::bf_lo(ov[j].y) * rstd * w4[2] * pg8::bf_lo(gv[j].y), pg8::bf_hi(ov[j].y) * rstd * w4[3] * pg8::bf_hi(gv[j].y));
                *(GAS u32x2*)(BG + tok * 2048 + h * 256 + 4 * lane) = r; } }
    }
}
struct Args { const float* in[12]; float* out; unsigned char* ws; int ph_lo, ph_hi, use_cg, dummy; };
constexpr int N_PHASES = 7;
__global__ void __launch_bounds__(NWAVES * 64, 2) hybrid_fwd(Args args) {
    extern __shared__ __attribute__((aligned(16))) unsigned char lds[];
    Frame F;
    F.lds = (LAS unsigned char*)lds;
    F.MISC = (volatile LAS unsigned*)(F.lds + MISC_OFF);
    F.tid = threadIdx.x; F.lane = F.tid & 63; F.wave = __builtin_amdgcn_readfirstlane(F.tid >> 6);
    F.G = gridDim.x; { const int bx = blockIdx.x; F.vcu = (F.G % 8 == 0) ? (bx % 8) * (F.G / 8) + bx / 8 : bx; }
    unsigned char* ws = args.ws;
    gu32* ctl = (gu32*)(ws + WS_CTL);
    const float* x = args.in[0]; const int* positions = (const int*)args.in[1]; const float* norm_w = args.in[2]; const float* w_in = args.in[3];
    const float* a_sinks = args.in[4]; const float* b_gate_up = args.in[5]; const float* b_gate_bias = args.in[6]; const float* b_out_norm_w = args.in[7];
    const float* w_a_proj = args.in[8]; const float* w_b_proj = args.in[9]; const float* w_out = args.in[10]; const float* final_norm_w = args.in[11];
    bf16* W1t = (bf16*)(ws + WS_W1); bf16* Wabt = (bf16*)(ws + WS_WA);     bf16* Wot = (bf16*)(ws + WS_WO);
    bf16* XN = (bf16*)(ws + WS_XN); bf16* Qb = (bf16*)(ws + WS_Q); bf16* KVb = (bf16*)(ws + WS_KV); bf16* BQb = (bf16*)(ws + WS_BQ); bf16* BKb = (bf16*)(ws + WS_BK);
    bf16* BVb = (bf16*)(ws + WS_BV); bf16* AGb = (bf16*)(ws + WS_AG); bf16* BGb = AGb + 1024;     float* LOGA = (float*)(ws + WS_LOGA);
    float* YA = (float*)(ws + WS_YA); bf16* MERGED = XN; bf16* OBU = XN; float* SS2 = (float*)(ws + WS_SS2); float* SSB = (float*)(ws + WS_SSB);
    bf16* MAb = (bf16*)args.out; bf16* MBb = MAb + (size_t)M * 1024;
    for (int u = F.tid; u < (LDS_BYTES - LDSCTL_OFF) / 4; u += NWAVES * 64) ((LAS unsigned*)(F.lds + LDSCTL_OFF))[u] = 0u;
    __syncthreads();
    XcdBarrier bar = xcd_barrier_post((unsigned*)(ctl + CW_BAR), F.MISC + 8);
    const int lo = args.ph_lo, hi = args.ph_hi;
#define IN(k) (lo <= (k) && (k) < hi)
#define BOTH(k) (IN(k) && IN((k) + 1))
#define GRID_BAR() do { if (args.use_cg) cg::this_grid().sync(); else xcd_barrier(bar); } while (0)
#ifdef PROBE_PHASE
#define STAMP(k) do { if (blockIdx.x == 0 && F.tid == 0) F.MISC[16 + (k)] = (unsigned)__builtin_amdgcn_s_memrealtime(); } while (0)
    STAMP(0);
#else
#define STAMP(k) do {} while (0)
#endif

    if (IN(0)) {
        LAS float* scr = (LAS float*)(F.lds + RING_OFF + F.wave * 16384);
        const int gw = F.vcu * NWAVES + F.wave, NGW = F.G * NWAVES;
        constexpr int I_1 = 16 * (7424 / 32), I_F = 16 * (512 / 32), I_S = 16 * 32;
        constexpr int NITEMS = I_1 + I_F;
        for (int it = gw; it < NITEMS; it += NGW) {
            int r = it;
            if (r < I_1) { const int kb = r / 232, nb = r % 232; p0_transpose_item(w_in, INW, 1024, W1t, 32 * nb, 64 * kb, src_col_w1(32 * nb + (F.lane & 31)), scr, F.lane); continue; } r -= I_1;
            { const int kb = r / 16, eb = r % 16; p0_fold_item(w_in, b_gate_up, W1t, 32 * eb, 64 * kb, scr, F.lane); }
        }
        for (int m = gw; m < M; m += 4 * NGW) rms_rows4_to_bf16(F.lane, x, norm_w, XN, m, NGW);
        for (int i = blockIdx.x * 512 + F.tid; i < M; i += F.G * 512) SS2[i] = 0.f;
        for (int i = blockIdx.x * 512 + F.tid; i < M * 4; i += F.G * 512) SSB[i] = 0.f;
        if (BOTH(0)) GRID_BAR();
        STAMP(1);
    }
    if (IN(1)) {
        const int n_full = (F.G == 256) ? 192 : 0;
        if ((int)blockIdx.x >= n_full) {
            LAS float* scr = (LAS float*)(F.lds + RING_OFF + F.wave * 16384);
            const int nb2 = F.G - n_full; const int gw2 = ((int)blockIdx.x - n_full) * NWAVES + F.wave, NGW2 = nb2 * NWAVES;
            constexpr int I_S = 16 * 32;
            for (int it = gw2; it < 3 * I_S; it += NGW2) {
                int r = it; const int mat = r / I_S; r -= mat * I_S; const int kb = r / 32, nb = r % 32;
                const float* Wsrc = mat == 0 ? w_a_proj : (mat == 1 ? w_b_proj : w_out); bf16* Wdst = mat == 0 ? Wabt : (mat == 1 ? Wabt + 1024 : Wot);
                p0_transpose_item(Wsrc, 1024, mat == 2 ? 1024 : 2048, Wdst, 32 * nb, 64 * kb, 32 * nb + (F.lane & 31), scr, F.lane);
            }
            asm volatile("s_waitcnt vmcnt(0) lgkmcnt(0)" ::: "memory");
#ifdef STAGGER_TICKS
            { const unsigned long long t0 = __builtin_amdgcn_s_memrealtime(); while (__builtin_amdgcn_s_memrealtime() - t0 < STAGGER_TICKS) __builtin_amdgcn_s_sleep(8); }
#endif
            __syncthreads();
        }
        pg8::Gemm g{XN, W1t, M, N1, D, D}; pg8::StaticOrder S; S.init(M, N1, F.G, (int)blockIdx.x);
        pg8::EpiP1 E{ws, (unsigned char*)args.out, positions, b_gate_bias};
        pg8::gemm_phase<pg8::EpiP1, pg8::StaticOrder, true, true>(F.lds + RING_OFF, g, S, E);
        if (BOTH(1)) GRID_BAR();
        STAMP(2);
    }
    if (IN(2)) {
        bf16* ATTG = (bf16*)(ws + WS_W1); float* DECG = (float*)(ws + WS_W1 + 8 * MiB);
        if (F.G == 256) {
            const int bh = F.vcu >> 3, sl = F.vcu & 7;
            unsigned* gc = (unsigned*)(ctl + CW_GLA + 64 * bh);
            const int au = F.vcu;
            const bool serial_first = (bh & 1) != 0;
            if (!serial_first && (F.vcu & 1)) attn_unit(F.lds + RING_OFF, au >> 5, (au >> 1) & 15, au & 1, Qb, KVb, AGb, a_sinks);
            gla_pre(F.lds + RING_OFF, bh, 4 * sl, 4, BQb, BKb, LOGA, ATTG, DECG);
            asm volatile("s_waitcnt vmcnt(0)" ::: "memory");
            __syncthreads();
            if (F.tid == 0) { __hip_atomic_fetch_add(gc, 1u, __ATOMIC_RELAXED, __HIP_MEMORY_SCOPE_AGENT); }
            STAMP(8);
            if (!serial_first && !(F.vcu & 1)) attn_unit(F.lds + RING_OFF, au >> 5, (au >> 1) & 15, au & 1, Qb, KVb, AGb, a_sinks);
            STAMP(9);
            if (F.tid == 0) { unsigned sp = 0; while (__hip_atomic_load(gc, __ATOMIC_RELAXED, __HIP_MEMORY_SCOPE_AGENT) < 8u) { __builtin_amdgcn_s_sleep(2); if (++sp > (1u << 22)) break; }
                __builtin_amdgcn_fence(__ATOMIC_ACQUIRE, "agent"); asm volatile("s_waitcnt vmcnt(0)" ::: "memory"); }
            __syncthreads();
            gla_serial(F.lds + RING_OFF, bh, sl, BQb, BKb, BVb, ATTG, DECG, OBU, SSB);
            STAMP(10);
            unsigned* gc2 = gc + 32;
            asm volatile("s_waitcnt vmcnt(0)" ::: "memory");
            __syncthreads();
            if (F.tid == 0) __hip_atomic_fetch_add(gc2, 1u, __ATOMIC_RELAXED, __HIP_MEMORY_SCOPE_AGENT);
            if (serial_first) attn_unit(F.lds + RING_OFF, au >> 5, (au >> 1) & 15, au & 1, Qb, KVb, AGb, a_sinks);
            if (F.tid == 0) { unsigned sp = 0; while (__hip_atomic_load(gc2, __ATOMIC_RELAXED, __HIP_MEMORY_SCOPE_AGENT) < 8u) { __builtin_amdgcn_s_sleep(2); if (++sp > (1u << 22)) break; }
                __builtin_amdgcn_fence(__ATOMIC_ACQUIRE, "agent"); asm volatile("s_waitcnt vmcnt(0)" ::: "memory"); }
            __syncthreads();
            gla_norm_rows(bh, 256 * sl, 256, F.wave, NWAVES, F.lane, OBU, BGb, SSB, b_out_norm_w);
            STAMP(11);
        } else {
            for (int it = F.vcu; it < 1024; it += F.G) gla_pre(F.lds + RING_OFF, it >> 5, it & 31, 1, BQb, BKb, LOGA, ATTG, DECG);
            GRID_BAR();
            for (int it = F.vcu; it < 256; it += F.G) gla_serial(F.lds + RING_OFF, it >> 3, it & 7, BQb, BKb, BVb, ATTG, DECG, OBU, SSB);
            for (int u = blockIdx.x; u < 256; u += F.G) attn_unit(F.lds + RING_OFF, u >> 5, (u >> 1) & 15, u & 1, Qb, KVb, AGb, a_sinks);
            GRID_BAR();
            for (int it = F.vcu; it < 256; it += F.G) gla_norm_rows(it >> 3, 256 * (it & 7), 256, F.wave, NWAVES, F.lane, OBU, BGb, SSB, b_out_norm_w);
        }
        if (BOTH(2)) GRID_BAR();
        STAMP(3);
    }
    STAMP(4);
    if (IN(4)) {
        pg8::Gemm g{AGb, Wabt, M, D, D, 2 * D}; pg8::StaticOrder2 S; S.init(M, D, F.G, (int)blockIdx.x);
        pg8::EpiMerge2 E{MAb, MBb, MERGED};
        pg8::gemm_phase<pg8::EpiMerge2, pg8::StaticOrder2, true, true, true>(F.lds + RING_OFF, g, S, E);
        if (BOTH(4)) GRID_BAR();
        STAMP(5);
    }
    const bool fuse_out = (F.G == 256);
    if (IN(5)) {
        pg8::Gemm g{MERGED, Wot, M, D, D, D}; pg8::StaticOrder S; S.init(M, D, F.G, (int)blockIdx.x);
        if (fuse_out) {
            pg8::EpiOutNorm E{x, args.out, SS2, (unsigned*)(ctl + CW_PANEL), final_norm_w};
            pg8::gemm_phase<pg8::EpiOutNorm, pg8::StaticOrder, false, true>(F.lds + RING_OFF, g, S, E);
        } else {
            pg8::EpiOut E{x, args.out, SS2};
            pg8::gemm_phase<pg8::EpiOut, pg8::StaticOrder, true, true>(F.lds + RING_OFF, g, S, E);
        }
        if (BOTH(5) && !fuse_out) GRID_BAR();
        STAMP(6);
    }
    if (IN(6) && !fuse_out) {
        const int gw = blockIdx.x * NWAVES + F.wave, NGW = F.G * NWAVES;
        for (int m = gw; m < M; m += NGW) {
            const float rstd = 1.0f / sqrtf(SS2[m] * (1.0f / D) + EPS);
            GAS f32x4* o = (GAS f32x4*)(args.out + (size_t)m * D) + F.lane; const GAS f32x4* fw = (const GAS f32x4*)final_norm_w + F.lane;
#pragma unroll
            for (int j = 0; j < 4; ++j) o[64 * j] = o[64 * j] * rstd * fw[64 * j];
        }
    }
#ifdef PROBE_PHASE
    STAMP(7);
    if (blockIdx.x == 0 && F.tid == 0) {
        const unsigned d = (PROBE_PHASE == 20 ? (F.MISC[16 + 8] - F.MISC[16 + 2]) : PROBE_PHASE == 21 ? (F.MISC[16 + 9] - F.MISC[16 + 8]) : PROBE_PHASE == 22 ? (F.MISC[16 + 3] - F.MISC[16 + 9]) : PROBE_PHASE == 23 ? (F.MISC[16 + 10] - F.MISC[16 + 9]) : PROBE_PHASE == 24 ? (F.MISC[16 + 11] - F.MISC[16 + 10]) : PROBE_PHASE == 25 ? (F.MISC[16 + 3] - F.MISC[16 + 11]) : PROBE_PHASE >= 30 ? F.MISC[26 + PROBE_PHASE - 29] : (F.MISC[16 + PROBE_PHASE + 1] - F.MISC[16 + PROBE_PHASE])) * 4u; const unsigned t0 = (unsigned)__builtin_amdgcn_s_memrealtime();
        while ((unsigned)__builtin_amdgcn_s_memrealtime() - t0 < d) __builtin_amdgcn_s_sleep(8);
    }
#endif
#undef IN
#undef BOTH
}

#ifndef MK_N_LAUNCHES
#define MK_N_LAUNCHES 1
#endif
#ifndef MK_USE_CG
#define MK_USE_CG 0
#endif
extern "C" void kernel_launch(void* const* d_in, const int* in_sizes, int n_in, void* d_out, int out_size, void* d_ws, size_t ws_size, hipStream_t stream) {
    static int grid = 0;
    if (grid == 0) {
        if (n_in != 12 || in_sizes[0] != M * D || out_size != M * D || ws_size < WS_END) { fprintf(stderr, "kernel_launch: unexpected shapes (n_in %d, in0 %d, out %d, ws %zu)\n", n_in, n_in > 0 ? in_sizes[0] : -1, out_size, ws_size); grid = -1; return; }
        int dev = 0, cus = 0, per_cu = 0;
        if (hipGetDevice(&dev) != hipSuccess || hipDeviceGetAttribute(&cus, hipDeviceAttributeMultiprocessorCount, dev) != hipSuccess) { grid = -1; return; }
        if (hipFuncSetAttribute((const void*)hybrid_fwd, hipFuncAttributeMaxDynamicSharedMemorySize, LDS_BYTES) != hipSuccess) { fprintf(stderr, "kernel_launch: hipFuncSetAttribute failed\n"); grid = -1; return; }
        if (hipOccupancyMaxActiveBlocksPerMultiprocessor(&per_cu, (const void*)hybrid_fwd, NWAVES * 64, LDS_BYTES) != hipSuccess || per_cu < 1) { fprintf(stderr, "kernel_launch: occupancy query says %d\n", per_cu); per_cu = 1; }
        (void)hipGetLastError();
        grid = cus;
    }
    if (grid < 0) return;
    if (hipMemsetAsync((char*)d_ws + WS_CTL, 0, CTL_ZERO_BYTES, stream) != hipSuccess) { fprintf(stderr, "kernel_launch: memset failed\n"); return; }
    Args a{};
    for (int i = 0; i < 12; ++i) a.in[i] = (const float*)d_in[i];
    a.out = (float*)d_out; a.ws = (unsigned char*)d_ws; a.use_cg = MK_USE_CG; a.dummy = 0;
    if (MK_N_LAUNCHES == 1) {
        a.ph_lo = 0; a.ph_hi = N_PHASES;
        void* kargs[] = {&a};
        hipError_t e = hipLaunchCooperativeKernel((const void*)hybrid_fwd, dim3(grid), dim3(NWAVES * 64), kargs, LDS_BYTES, stream);
        if (e != hipSuccess) fprintf(stderr, "kernel_launch: cooperative launch failed: %s (grid %d)\n", hipGetErrorString(e), grid);
    } else {
        for (int li = 0; li < N_PHASES; ++li) {
            a.ph_lo = li; a.ph_hi = li + 1;
#ifdef PROBE_DUP
            if (li == PROBE_DUP) { a.dummy = (li == 2); hipLaunchKernelGGL(hybrid_fwd, dim3(grid), dim3(NWAVES * 64), LDS_BYTES, stream, a); a.dummy = 0; }
#endif
            hipLaunchKernelGGL(hybrid_fwd, dim3(grid), dim3(NWAVES * 64), LDS_BYTES, stream, a);
        }
    }
}
```
